# Optimizing an MI355X kernel written in HIP

```python
import jax, jax.numpy as jnp
from jax import lax
import numpy as np

D_MODEL = 2048
BATCH = 4
SEQ = 4096
DEPTH = 2

HEAD_DIM = 64
HALF_DIM = HEAD_DIM // 2
SCALE = HEAD_DIM ** -0.5
NORM_EPS = 1e-6
ROPE_THETA = 10000.0
NEG_INF = -1e30

RW_HEADS = 8
RW_WIDTH = RW_HEADS * HEAD_DIM
RW_DECAY_LORA = 32
RW_AAA_LORA = 32
RW_GATE_LORA = 96
RW_LNX_EPS = 64e-5
RW_SPLITS = (RW_WIDTH, RW_WIDTH, RW_WIDTH, 2 * RW_DECAY_LORA, 2 * RW_AAA_LORA, RW_GATE_LORA)
RW_COLS = sum(RW_SPLITS)

DIL_PATTERNS = ((128, 1), (512, 4), (2048, 16))
DIL_GROUPS = len(DIL_PATTERNS)
DIL_HEADS_PER_GROUP = 4
DIL_HEADS = DIL_GROUPS * DIL_HEADS_PER_GROUP
DIL_WIDTH = DIL_HEADS * HEAD_DIM
DIL_OUT_WIDTH = DIL_HEADS_PER_GROUP * HEAD_DIM
DIL_BLOCK = 64

GRID_W = 64
NA_HEADS = 12
NA_WIDTH = NA_HEADS * HEAD_DIM
NA_KH = 8
NA_KW = 16
NA_QCB = 16
NA_KCB = 32

N_BRANCH = 3
IN_SPLITS = (RW_COLS, DIL_WIDTH, DIL_WIDTH, DIL_WIDTH, NA_WIDTH, NA_WIDTH, NA_WIDTH, N_BRANCH * D_MODEL)
IN_COLS = sum(IN_SPLITS)

D_FF = 5632
PLE_DIM = 256

kernel_name = 'hybrid_rwkv7_dilated_natten_encoder'


def _split(z, sizes):
    idx = [int(s) for s in np.cumsum(sizes)[:-1]]
    return jnp.split(z, idx, axis=-1)


def rmsnorm(z, g):
    zf = z.astype(jnp.float32)
    zf = zf * lax.rsqrt(jnp.mean(zf * zf, axis=-1, keepdims=True) + NORM_EPS)
    return (zf * g).astype(z.dtype)


def centred_shift(z):
    zp = jnp.pad(z, ((0, 0), (1, 1), (0, 0)))
    return 0.5 * (zp[:, :-2] + zp[:, 2:])


def rope_tables(T):
    inv = ROPE_THETA ** (-jnp.arange(0, HEAD_DIM, 2, dtype=jnp.float32) / HEAD_DIM)
    ang = jnp.arange(T, dtype=jnp.float32)[:, None] * inv[None, :]
    return jnp.cos(ang), jnp.sin(ang)


def apply_rope(z, cos, sin):
    zf = z.astype(jnp.float32)
    z1, z2 = zf[..., :HALF_DIM], zf[..., HALF_DIM:]
    c, s = cos[:, None, :], sin[:, None, :]
    return jnp.concatenate([z1 * c - z2 * s, z2 * c + z1 * s], axis=-1).astype(z.dtype)


def rwkv7_step(S, inp):
    r_t, w_t, k_t, v_t, a_t, b_t = inp
    sa = jnp.einsum('dbhij,dbhj->dbhi', S, a_t)
    S = S * w_t[..., None, :] + sa[..., :, None] * b_t[..., None, :] + v_t[..., :, None] * k_t[..., None, :]
    y = jnp.einsum('dbhij,dbhj->dbhi', S, r_t)
    return S, y


def rwkv7_bidir(cols, mu, w0, w2, a0, a2, g2, k_k, k_a, r_k, lnx_g, lnx_b):
    dt = cols.dtype
    c = cols.astype(jnp.float32)
    c = c + mu * (centred_shift(c) - c)
    r, k, v, wd, ad, gd = _split(c, RW_SPLITS)
    B, T, C = r.shape
    H, N = RW_HEADS, HEAD_DIM
    wd = wd.reshape(B, T, 2, RW_DECAY_LORA)
    ad = ad.reshape(B, T, 2, RW_AAA_LORA)
    w = -jax.nn.softplus(-(w0 + jnp.einsum('btdl,dlc->btdc', jnp.tanh(wd), w2))) - 0.5
    decay = jnp.exp(-jnp.exp(w))
    lr = jax.nn.sigmoid(a0 + jnp.einsum('btdl,dlc->btdc', ad, a2))
    gate = jax.nn.sigmoid(gd) @ g2
    kk = (k * k_k).reshape(B, T, H, N)
    kk = kk / jnp.maximum(jnp.linalg.norm(kk, axis=-1, keepdims=True), 1e-12)
    kd = k[:, :, None] * (1.0 + (lr - 1.0) * k_a)
    heads = lambda z: z.reshape(z.shape[:-1] + (H, N))
    r_h, v_h = heads(r), heads(v)
    kd_h, decay_h, lr_h = heads(kd), heads(decay), heads(lr)
    both = lambda z: jnp.broadcast_to(z[:, :, None], kd_h.shape)
    kk2 = both(kk)

    def to_scan(z):
        z = jnp.stack([z[:, :, 0], z[:, ::-1, 1]], axis=0)
        return jnp.moveaxis(z, 2, 0)

    xs = (to_scan(both(r_h)), to_scan(decay_h), to_scan(kd_h), to_scan(both(v_h)),
          to_scan(-kk2), to_scan(kk2 * lr_h))
    S0 = jnp.zeros((2, B, H, N, N), jnp.float32)
    _, ys = lax.scan(rwkv7_step, S0, xs)
    y = jnp.moveaxis(ys[:, 0], 0, 1) + jnp.moveaxis(ys[::-1, 1], 0, 1)
    mean = jnp.mean(y, axis=-1, keepdims=True)
    var = jnp.mean(jnp.square(y - mean), axis=-1, keepdims=True)
    yn = ((y - mean) * lax.rsqrt(var + RW_LNX_EPS)).reshape(B, T, C) * lnx_g + lnx_b
    bonus = jnp.sum(jnp.sum(r_h[:, :, None] * kd_h * r_k, axis=-1, keepdims=True) * v_h[:, :, None], axis=2)
    return ((yn + bonus.reshape(B, T, C)) * gate).astype(dt)


def dilated_band(q, k, v, half, dil):
    B, T, H, E = q.shape
    n_sub = T // dil
    ns = -(-half // DIL_BLOCK)
    kw = (2 * ns + 1) * DIL_BLOCK
    nblk = -(-n_sub // DIL_BLOCK)
    n_pad = nblk * DIL_BLOCK
    sub = lambda z: jnp.swapaxes(z.reshape(B, n_sub, dil, H, E), 1, 2)
    qs = jnp.pad(sub(q), ((0, 0), (0, 0), (0, n_pad - n_sub), (0, 0), (0, 0)))
    qs = qs.reshape(B, dil, nblk, DIL_BLOCK, H, E)
    padk = ((0, 0), (0, 0), (ns * DIL_BLOCK, n_pad - n_sub + ns * DIL_BLOCK), (0, 0), (0, 0))

    def windows(z):
        zb = jnp.pad(sub(z), padk).reshape(B, dil, nblk + 2 * ns, DIL_BLOCK, H, E)
        return jnp.concatenate([zb[:, :, s:s + nblk] for s in range(2 * ns + 1)], axis=3)

    kwin, vwin = windows(k), windows(v)
    jq = np.arange(nblk)[:, None] * DIL_BLOCK + np.arange(DIL_BLOCK)[None, :]
    jk = np.arange(nblk)[:, None] * DIL_BLOCK - ns * DIL_BLOCK + np.arange(kw)[None, :]
    ok = ((np.abs(jk[:, None, :] - jq[:, :, None]) <= half)
          & (jk[:, None, :] >= 0) & (jk[:, None, :] < n_sub))
    s = jnp.einsum('briqhe,brimhe->brihqm', qs, kwin, preferred_element_type=jnp.float32)
    s = jnp.where(jnp.asarray(ok)[None, None, :, None, :, :], s, NEG_INF)
    lse = jax.nn.logsumexp(s, axis=-1)
    pr = jnp.exp(s - lse[..., None])
    o = jnp.einsum('brihqm,brimhe->briqhe', pr, vwin.astype(jnp.float32))
    o = jnp.swapaxes(o.reshape(B, dil, n_pad, H, E)[:, :, :n_sub], 1, 2).reshape(B, T, H, E)
    lse = jnp.transpose(lse, (0, 1, 2, 4, 3)).reshape(B, dil, n_pad, H)[:, :, :n_sub]
    lse = jnp.swapaxes(lse, 1, 2).reshape(B, T, H)
    return o, lse


def dilated_attention(q, k, v, cos, sin):
    B, T, _ = q.shape
    q = apply_rope(q.reshape(B, T, DIL_HEADS, HEAD_DIM), cos, sin) * SCALE
    k = apply_rope(k.reshape(B, T, DIL_HEADS, HEAD_DIM), cos, sin)
    v = v.reshape(B, T, DIL_HEADS, HEAD_DIM)
    outs, lses = [], []
    for g, (window, dil) in enumerate(DIL_PATTERNS):
        hs = slice(g * DIL_HEADS_PER_GROUP, (g + 1) * DIL_HEADS_PER_GROUP)
        o, l = dilated_band(q[:, :, hs], k[:, :, hs], v[:, :, hs], window // (2 * dil), dil)
        outs.append(o)
        lses.append(l)
    wts = jax.nn.softmax(jnp.stack(lses, axis=0), axis=0)
    o = jnp.einsum('gbth,gbthe->bthe', wts, jnp.stack(outs, axis=0))
    return o.reshape(B, T, DIL_OUT_WIDTH).astype(v.dtype)


def neighbourhood_attention(q, k, v, rel_bias):
    B, T, _ = q.shape
    rows = T // GRID_W
    kh = min(NA_KH, rows)
    n_cb = GRID_W // NA_QCB
    qc = np.arange(GRID_W).reshape(n_cb, NA_QCB)
    kc0 = np.clip(np.arange(n_cb) * NA_QCB - NA_KW // 2, 0, GRID_W - NA_KCB)
    kc = kc0[:, None] + np.arange(NA_KCB)[None, :]
    wc0 = np.clip(qc - NA_KW // 2, 0, GRID_W - NA_KW)
    col_ok = jnp.asarray((kc[:, None, :] >= wc0[:, :, None]) & (kc[:, None, :] < wc0[:, :, None] + NA_KW))
    dx_idx = np.clip(kc[:, None, :] - qc[:, :, None], 1 - NA_KW, NA_KW - 1) + NA_KW - 1
    qg = (q * SCALE).reshape(B, rows, n_cb, NA_QCB, NA_HEADS, HEAD_DIM)
    kg = k.reshape(B, rows, GRID_W, NA_HEADS, HEAD_DIM)
    vg = v.reshape(B, rows, GRID_W, NA_HEADS, HEAD_DIM)

    def row_fn(r):
        r0 = jnp.clip(r - kh // 2, 0, rows - kh)
        k_blk = lax.dynamic_slice_in_dim(kg, r0, kh, axis=1)[:, :, kc]
        v_blk = lax.dynamic_slice_in_dim(vg, r0, kh, axis=1)[:, :, kc]
        q_r = lax.dynamic_index_in_dim(qg, r, axis=1, keepdims=False)
        s = jnp.einsum('bcqhe,bycmhe->bhcqym', q_r, k_blk, preferred_element_type=jnp.float32)
        dy = r0 + jnp.arange(kh) - r
        bias = rel_bias[:, dy + NA_KH - 1][:, :, dx_idx]
        s = s + jnp.transpose(bias, (0, 2, 3, 1, 4))[None].astype(jnp.float32)
        s = jnp.where(col_ok[None, None, :, :, None, :], s, NEG_INF)
        pr = jax.nn.softmax(s, axis=(-2, -1))
        return jnp.einsum('bhcqym,bycmhe->bcqhe', pr, v_blk.astype(jnp.float32))

    out = lax.map(row_fn, jnp.arange(rows))
    return jnp.moveaxis(out, 0, 1).reshape(B, T, NA_WIDTH).astype(v.dtype)


def conv_ffn(h, w_gate, w_up, conv_w, conv_b, w_down):
    gp = jnp.pad(h @ w_gate, ((0, 0), (1, 1), (0, 0)))
    gc = gp[:, :-2] * conv_w[0] + gp[:, 1:-1] * conv_w[1] + gp[:, 2:] * conv_w[2] + conv_b
    return (jax.nn.gelu(gc) * (h @ w_up)) @ w_down


def setup_inputs(seed: int = 0) -> dict:
    key = jax.random.key(seed)
    ks = iter(jax.random.split(key, 32))
    nrm = lambda shape, scale: scale * jax.random.normal(next(ks), shape, jnp.float32)
    L, C = DEPTH, RW_WIDTH
    return {
        'x': nrm((BATCH, SEQ, D_MODEL), 1.0),
        'p': nrm((DEPTH, BATCH, SEQ, PLE_DIM), 1.0),
        'norm_mix': 1.0 + nrm((L, D_MODEL), 0.02),
        'w_in': nrm((L, D_MODEL, IN_COLS), D_MODEL ** -0.5),
        'rw_mu': jax.random.uniform(next(ks), (L, RW_COLS), jnp.float32),
        'rw_w0': jax.random.uniform(next(ks), (L, 2, C), jnp.float32, -5.0, 1.0),
        'rw_w2': nrm((L, 2, RW_DECAY_LORA, C), 0.1),
        'rw_a0': nrm((L, 2, C), 0.5),
        'rw_a2': nrm((L, 2, RW_AAA_LORA, C), 0.5 * RW_AAA_LORA ** -0.5),
        'rw_g2': nrm((L, RW_GATE_LORA, C), RW_GATE_LORA ** -0.5),
        'rw_k_k': 0.85 + nrm((L, C), 0.05),
        'rw_k_a': 1.0 + nrm((L, C), 0.05),
        'rw_r_k': nrm((L, RW_HEADS, HEAD_DIM), 0.1),
        'rw_lnx_g': 1.0 + nrm((L, C), 0.02),
        'rw_lnx_b': nrm((L, C), 0.02),
        'na_bias': nrm((L, NA_HEADS, 2 * NA_KH - 1, 2 * NA_KW - 1), 0.1),
        'w_br_a': nrm((L, RW_WIDTH, D_MODEL), RW_WIDTH ** -0.5),
        'w_br_b': nrm((L, DIL_OUT_WIDTH, D_MODEL), DIL_OUT_WIDTH ** -0.5),
        'w_br_c': nrm((L, NA_WIDTH, D_MODEL), NA_WIDTH ** -0.5),
        'w_out': nrm((L, D_MODEL, D_MODEL), D_MODEL ** -0.5),
        'norm_ffn': 1.0 + nrm((L, D_MODEL), 0.02),
        'w_ffn_gate': nrm((L, D_MODEL, D_FF), D_MODEL ** -0.5),
        'w_ffn_up': nrm((L, D_MODEL, D_FF), D_MODEL ** -0.5),
        'ffn_conv_w': nrm((L, 3, D_FF), 3 ** -0.5),
        'ffn_conv_b': nrm((L, D_FF), 0.02),
        'w_ffn_down': nrm((L, D_FF, D_MODEL), D_FF ** -0.5),
        'norm_ple': 1.0 + nrm((L, D_MODEL), 0.02),
        'w_ple_gate': nrm((L, D_MODEL, D_MODEL), D_MODEL ** -0.5),
        'w_ple': nrm((L, PLE_DIM, D_MODEL), PLE_DIM ** -0.5),
        'norm_final': 1.0 + nrm((D_MODEL,), 0.02),
    }


def reference(x, p, norm_mix, w_in, rw_mu, rw_w0, rw_w2, rw_a0, rw_a2, rw_g2, rw_k_k, rw_k_a,
              rw_r_k, rw_lnx_g, rw_lnx_b, na_bias, w_br_a, w_br_b, w_br_c, w_out, norm_ffn,
              w_ffn_gate, w_ffn_up, ffn_conv_w, ffn_conv_b, w_ffn_down, norm_ple, w_ple_gate,
              w_ple, norm_final):
    T = x.shape[1]
    cos, sin = rope_tables(T)
    for i in range(DEPTH):
        h = rmsnorm(x, norm_mix[i])
        rw_cols, dq, dk, dv, nq, nk, nv, gates = _split(h @ w_in[i], IN_SPLITS)
        ya = rwkv7_bidir(rw_cols, rw_mu[i], rw_w0[i], rw_w2[i], rw_a0[i], rw_a2[i], rw_g2[i],
                         rw_k_k[i], rw_k_a[i], rw_r_k[i], rw_lnx_g[i], rw_lnx_b[i])
        yb = dilated_attention(dq, dk, dv, cos, sin)
        yc = neighbourhood_attention(nq, nk, nv, na_bias[i])
        ga, gb, gc = jnp.split(jax.nn.sigmoid(gates), N_BRANCH, axis=-1)
        merged = ga * (ya @ w_br_a[i]) + gb * (yb @ w_br_b[i]) + gc * (yc @ w_br_c[i])
        x = x + merged @ w_out[i]
        h = rmsnorm(x, norm_ffn[i])
        x = x + conv_ffn(h, w_ffn_gate[i], w_ffn_up[i], ffn_conv_w[i], ffn_conv_b[i], w_ffn_down[i])
        h = rmsnorm(x, norm_ple[i])
        x = x + jax.nn.sigmoid(h @ w_ple_gate[i]) * (p[i] @ w_ple[i])
    return rmsnorm(x, norm_final)
```

```cpp
#include <hip/hip_runtime.h>
#include <hip/hip_cooperative_groups.h>
#include <cstdio>
#include <cstdint>
namespace cg = cooperative_groups;

#define GAS __attribute__((address_space(1)))
#define LAS __attribute__((address_space(3)))
typedef _Float16 hf;
typedef _Float16 hf8 __attribute__((ext_vector_type(8)));
typedef _Float16 hf4 __attribute__((ext_vector_type(4)));
typedef _Float16 hf2 __attribute__((ext_vector_type(2)));
typedef float f32x4 __attribute__((ext_vector_type(4)));
typedef float f32x2 __attribute__((ext_vector_type(2)));
typedef unsigned u32x4 __attribute__((ext_vector_type(4)));
typedef unsigned u32x2 __attribute__((ext_vector_type(2)));

constexpr int M = 16384, D = 2048, T = 4096, FF = 5632, PLE = 256;
constexpr int IN_COLS = 12512, RW_COLS = 1760, RWP = 1792, QKVW = 4608, NIN1 = 6400, NGATE = 6144, NINP = 12544;
constexpr int NWAVES = 8, NTHR = 512;
constexpr int GA_EARLY = 1024;
constexpr int GA_SPLIT = 12288;
constexpr int LDS_BYTES = 131072 + 2048;

constexpr size_t MiB = (size_t)1 << 20;
constexpr size_t WS_WIN = 0, WS_WA = 49 * MiB, WS_WB = 51 * MiB, WS_WC = 52 * MiB, WS_WO = 55 * MiB, WS_WG = 63 * MiB, WS_WU = 85 * MiB, WS_WD = 107 * MiB,
                 WS_WPG = 129 * MiB, WS_WP = 137 * MiB, WS_ROPE = 138 * MiB, WS_P16 = 139 * MiB, WS_H = 155 * MiB, WS_Z = 219 * MiB;
constexpr size_t Z_RWBUF = WS_Z, Z_YF = WS_Z, Z_YBK = WS_Z + 32 * MiB, Z_GRW = WS_Z + 112 * MiB, Z_BONUS = WS_Z + 128 * MiB, Z_QKV = WS_Z + 144 * MiB,
                 Z_S1 = WS_Z + 288 * MiB, Z_S2 = WS_Z + 336 * MiB, Z_YA = WS_Z + 432 * MiB, Z_YB = WS_Z + 448 * MiB, Z_YC = WS_Z + 456 * MiB,
                 Z_DILO = WS_Z + 480 * MiB, Z_LSE = WS_Z + 504 * MiB, WS_END = WS_Z + 505 * MiB;
constexpr size_t Z_SG = WS_Z + 432 * MiB;
constexpr size_t Z_GATES = WS_Z + 144 * MiB, Z_MACC = WS_Z, Z_G = WS_Z, Z_ACT = WS_Z + 176 * MiB, Z_PP = WS_Z + 352 * MiB;

__device__ __forceinline__ unsigned pkh(float a, float b) { hf2 h = {(hf)a, (hf)b}; return __builtin_bit_cast(unsigned, h); }
__device__ __forceinline__ float sigmoidf_(float x) { return __builtin_amdgcn_rcpf(1.0f + __expf(-x)); }
__device__ __forceinline__ float dpp_allsum16(float x) {
    x += __builtin_bit_cast(float, __builtin_amdgcn_update_dpp(0, __builtin_bit_cast(int, x), 0xB1, 0xF, 0xF, false));
    x += __builtin_bit_cast(float, __builtin_amdgcn_update_dpp(0, __builtin_bit_cast(int, x), 0x4E, 0xF, 0xF, false));
    x += __builtin_bit_cast(float, __builtin_amdgcn_update_dpp(0, __builtin_bit_cast(int, x), 0x141, 0xF, 0xF, false));
    x += __builtin_bit_cast(float, __builtin_amdgcn_update_dpp(0, __builtin_bit_cast(int, x), 0x140, 0xF, 0xF, false));
    return x;
}
__device__ __forceinline__ float xor_shfl(float v, int lane, int mask) { return __builtin_bit_cast(float, __builtin_amdgcn_ds_bpermute((lane ^ mask) << 2, __builtin_bit_cast(int, v))); }
__device__ __forceinline__ float wave_sum(float v, int lane) { v = dpp_allsum16(v); v += xor_shfl(v, lane, 16); v += xor_shfl(v, lane, 32); return v; }
__device__ __forceinline__ u32x4 pack8(const f32x4 a, const f32x4 b) { u32x4 o; o.x = pkh(a.x, a.y); o.y = pkh(a.z, a.w); o.z = pkh(b.x, b.y); o.w = pkh(b.z, b.w); return o; }
__device__ __forceinline__ void unpack8(const u32x4 v, f32x4& a, f32x4& b) {
    const unsigned x0 = v.x, x1 = v.y, x2 = v.z, x3 = v.w;
    hf2 h0 = __builtin_bit_cast(hf2, x0), h1 = __builtin_bit_cast(hf2, x1), h2 = __builtin_bit_cast(hf2, x2), h3 = __builtin_bit_cast(hf2, x3);
    a = (f32x4){(float)h0.x, (float)h0.y, (float)h1.x, (float)h1.y}; b = (f32x4){(float)h2.x, (float)h2.y, (float)h3.x, (float)h3.y};
}

namespace pg8 {
#define PG8_LAS __attribute__((address_space(3)))
typedef unsigned short bf16_t;
typedef short bf16x8 __attribute__((ext_vector_type(8)));
constexpr int BM = 256, BK = 64, HALF = 128, HTB = HALF * BK * 2  , STAGE_BYTES = 8 * HTB, NXCD = 8, WGM = 8;

__host__ __device__ __forceinline__ int lds_byte(int r, int c) { const int st = (r >> 4) * 2 + (c >> 5), rr = r & 15, cc = c & 31, ob = rr * 64 + cc * 2; return st * 1024 + (ob ^ (((ob >> 9) & 1) << 5)); }
__host__ __device__ __forceinline__ void stage_rc(int b, int& R, int& C) { const int st = b / 1024, sb = b % 1024, swz = sb ^ (((sb >> 9) & 1) << 5); R = (st >> 1) * 16 + swz / 64; C = (st & 1) * 32 + (swz % 64) / 2; }
__host__ __device__ __forceinline__ int perm32(int rho) { const int n = rho >> 4, i = rho & 15; return 8 * (i >> 2) + 4 * n + (i & 3); }

struct Unit { int pm, pn; };
struct Gemm { const bf16_t* A; const bf16_t* Bt; int M, N, K; };

struct StaticOrder {
    int nM, nN, nwg, G, c;
    __host__ __device__ void init(int M, int N, int G_, int c_) { nM = M / BM; nN = N / BM; nwg = nM * nN; G = G_; c = c_; }
    __host__ __device__ bool next(int i, Unit& u) const {
        const long L = (long)i * G + c; if (L >= nwg) return false;
        int wgid = (int)L; { const int q = nwg / NXCD, r = nwg % NXCD, xcd = wgid % NXCD, off = wgid / NXCD; wgid = (xcd < r ? xcd * (q + 1) : r * (q + 1) + (xcd - r) * q) + off; }
        const int nig = WGM * nN, gid = wgid / nig, fm = gid * WGM, gsz = (nM - fm) < WGM ? (nM - fm) : WGM;
        u.pm = fm + ((wgid % nig) % gsz); u.pn = (wgid % nig) / gsz; return true;
    }
    __device__ __forceinline__ void a_ready(const Unit&) const {}
    __device__ __forceinline__ void done(const Unit&) const {}
};

#define EPI_LOOP_BEGIN \
    _Pragma("unroll") for (int bj = 0; bj < 2; ++bj) { const int col = u.pn * BM + bj * HALF + wc * 32 + 8 * fq; (void)col;
#define EPI_ROWS_BEGIN \
    _Pragma("unroll") for (int ai = 0; ai < 2; ++ai) { _Pragma("unroll") for (int m = 0; m < 4; ++m) { const int row = u.pm * BM + ai * HALF + wr * 64 + m * 16 + fr; const f32x4 v0 = acc[ai][bj][m][0], v1 = acc[ai][bj][m][1];
#define EPI_END } } }
typedef f32x4 Acc[2][2][4][2];

struct EpiIn1 {
    static constexpr bool PERM = true, AFTER_DRAIN = false;
    float* rw; hf* qkv;
    __device__ __forceinline__ void operator()(const Acc& acc, const Unit& u, int wr, int wc, int fr, int fq) const {
        if (u.pn < 7) {
            EPI_LOOP_BEGIN EPI_ROWS_BEGIN
                float* p = rw + (size_t)row * RWP + col; *(f32x4*)p = v0; *(f32x4*)(p + 4) = v1;
            EPI_END
        } else {
            EPI_LOOP_BEGIN EPI_ROWS_BEGIN
                *(u32x4*)(qkv + (size_t)row * QKVW + (col - 7 * BM)) = pack8(v0, v1);
            EPI_END
        }
    }
};
struct EpiGates {
    static constexpr bool PERM = true, AFTER_DRAIN = false;
    hf* O; int ldc; int split_row; hf* O2; int csplit; hf* P2; int ldp;
    __device__ __forceinline__ void operator()(const Acc& acc, const Unit& u, int wr, int wc, int fr, int fq) const {
        const bool first = u.pn * BM < csplit;
        EPI_LOOP_BEGIN EPI_ROWS_BEGIN
            f32x4 a, b;
#pragma unroll
            for (int i = 0; i < 4; ++i) { a[i] = sigmoidf_(v0[i]); b[i] = sigmoidf_(v1[i]); }
            hf* base = first ? (row < split_row ? O + (size_t)row * ldc : O2 + (size_t)(row - split_row) * ldc) + col : P2 + (size_t)row * ldp + (col - csplit);
            *(u32x4*)base = pack8(a, b);
        EPI_END
    }
};
struct EpiF16 {
    static constexpr bool PERM = true, AFTER_DRAIN = false;
    hf* O; int ldc;
    __device__ __forceinline__ void operator()(const Acc& acc, const Unit& u, int wr, int wc, int fr, int fq) const {
        EPI_LOOP_BEGIN EPI_ROWS_BEGIN
            *(u32x4*)(O + (size_t)row * ldc + col) = pack8(v0, v1);
        EPI_END
    }
};
template <int MODE> struct EpiBranch {
    static constexpr bool PERM = true, AFTER_DRAIN = false;
    const hf* gates; int goff; float* macc; hf* merged;
    __device__ __forceinline__ void operator()(const Acc& acc, const Unit& u, int wr, int wc, int fr, int fq) const {
        EPI_LOOP_BEGIN EPI_ROWS_BEGIN
            f32x4 g0, g1; unpack8(*(const u32x4*)(gates + (size_t)row * NGATE + goff + col), g0, g1);
            float* p = macc + (size_t)row * D + col;
            f32x4 r0 = g0 * v0, r1 = g1 * v1;
            if (MODE >= 1) { r0 += *(const f32x4*)p; r1 += *(const f32x4*)(p + 4); }
            if (MODE <= 1) { *(f32x4*)p = r0; *(f32x4*)(p + 4) = r1; }
            else *(u32x4*)(merged + (size_t)row * D + col) = pack8(r0, r1);
        EPI_END
    }
};
struct EpiMerge {
    static constexpr bool PERM = true, AFTER_DRAIN = false;
    const hf* ga1; const hf* ga2; const hf* gbc; const hf* A16; const hf* B16; hf* merged;
    __device__ __forceinline__ void operator()(const Acc& acc, const Unit& u, int wr, int wc, int fr, int fq) const {
#pragma unroll
        for (int bj = 0; bj < 2; ++bj) {
            const int col = u.pn * BM + bj * HALF + wc * 32 + 8 * fq;
#pragma unroll
            for (int ai = 0; ai < 2; ++ai)
#pragma unroll
                for (int mh = 0; mh < 2; ++mh) {
                    u32x4 ra[2], rb[2], rc[2], rx[2], ry[2];
#pragma unroll
                    for (int mm = 0; mm < 2; ++mm) { const int row = u.pm * BM + ai * HALF + wr * 64 + (2 * mh + mm) * 16 + fr; const hf* gp = gbc + (size_t)row * (2 * D) + col; const hf* ap = row < GA_SPLIT ? ga1 + (size_t)row * D : ga2 + (size_t)(row - GA_SPLIT) * D;
                        ra[mm] = *(const u32x4*)(ap + col); rb[mm] = *(const u32x4*)gp; rc[mm] = *(const u32x4*)(gp + D);
                        rx[mm] = *(const u32x4*)(A16 + (size_t)row * D + col); ry[mm] = *(const u32x4*)(B16 + (size_t)row * D + col); }
                    asm volatile("" ::: "memory");
#pragma unroll
                    for (int mm = 0; mm < 2; ++mm) { const int m = 2 * mh + mm, row = u.pm * BM + ai * HALF + wr * 64 + m * 16 + fr;
                        f32x4 ga0, ga1, gb0, gb1, gc0, gc1, a0, a1, b0, b1;
                        unpack8(ra[mm], ga0, ga1); unpack8(rb[mm], gb0, gb1); unpack8(rc[mm], gc0, gc1); unpack8(rx[mm], a0, a1); unpack8(ry[mm], b0, b1);
                        *(u32x4*)(merged + (size_t)row * D + col) = pack8(ga0 * a0 + gb0 * b0 + gc0 * acc[ai][bj][m][0], ga1 * a1 + gb1 * b1 + gc1 * acc[ai][bj][m][1]); }
                    asm volatile("" ::: "memory");
                }
        }
    }
};
struct EpiResid {
    static constexpr bool PERM = true, AFTER_DRAIN = false;
    const float* xin; float* xout;
    __device__ __forceinline__ void operator()(const Acc& acc, const Unit& u, int wr, int wc, int fr, int fq) const {
#pragma unroll
        for (int bj = 0; bj < 2; ++bj) {
            const int col = u.pn * BM + bj * HALF + wc * 32 + 8 * fq;
#pragma unroll
            for (int ai = 0; ai < 2; ++ai) {
                f32x4 xa[4], xb[4];
#pragma unroll
                for (int m = 0; m < 4; ++m) { const float* p = xin + (size_t)(u.pm * BM + ai * HALF + wr * 64 + m * 16 + fr) * D + col; xa[m] = *(const f32x4*)p; xb[m] = *(const f32x4*)(p + 4); }
                asm volatile("" ::: "memory");
#pragma unroll
                for (int m = 0; m < 4; ++m) { float* q = xout + (size_t)(u.pm * BM + ai * HALF + wr * 64 + m * 16 + fr) * D + col;
                    *(f32x4*)q = xa[m] + acc[ai][bj][m][0]; *(f32x4*)(q + 4) = xb[m] + acc[ai][bj][m][1]; }
                asm volatile("" ::: "memory");
            }
        }
    }
};
__device__ __forceinline__ float gelu_tanh(float x) {
    const float u2 = 1.5957691216f * (x + 0.044715f * x * x * x);
    return x * __builtin_amdgcn_rcpf(1.0f + __expf(-u2));
}
struct EpiUp {
    static constexpr bool PERM = true, AFTER_DRAIN = false;
    const hf* G; const float* cw; const float* cb; hf* O;
    __device__ __forceinline__ void operator()(const Acc& acc, const Unit& u, int wr, int wc, int fr, int fq) const {
#pragma unroll
        for (int bj = 0; bj < 2; ++bj) {
            const int col = u.pn * BM + bj * HALF + wc * 32 + 8 * fq;
            const f32x4 w0a = *(const f32x4*)(cw + col), w0b = *(const f32x4*)(cw + col + 4), w1a = *(const f32x4*)(cw + FF + col), w1b = *(const f32x4*)(cw + FF + col + 4),
                        w2a = *(const f32x4*)(cw + 2 * FF + col), w2b = *(const f32x4*)(cw + 2 * FF + col + 4), ba = *(const f32x4*)(cb + col), bb = *(const f32x4*)(cb + col + 4);
#pragma unroll
            for (int ai = 0; ai < 2; ++ai) {
#pragma unroll
                for (int mh = 0; mh < 2; ++mh) {
                    u32x4 rc[2], rm[2], rp[2];
#pragma unroll
                    for (int mm = 0; mm < 2; ++mm) {
                        const int m = 2 * mh + mm, row = u.pm * BM + ai * HALF + wr * 64 + m * 16 + fr, t = row & (T - 1);
                        const hf* gp = G + (size_t)row * FF + col;
                        rc[mm] = *(const u32x4*)gp; rm[mm] = *(const u32x4*)(t > 0 ? gp - FF : gp); rp[mm] = *(const u32x4*)(t < T - 1 ? gp + FF : gp);
                    }
                    asm volatile("" ::: "memory");
#pragma unroll
                    for (int mm = 0; mm < 2; ++mm) {
                        const int m = 2 * mh + mm, row = u.pm * BM + ai * HALF + wr * 64 + m * 16 + fr, t = row & (T - 1);
                        const f32x4 v0 = acc[ai][bj][m][0], v1 = acc[ai][bj][m][1];
                        const float fm = t > 0 ? 1.0f : 0.0f, fp_ = t < T - 1 ? 1.0f : 0.0f;
                        f32x4 c0, c1, m0, m1, p0, p1;
                        unpack8(rc[mm], c0, c1); unpack8(rm[mm], m0, m1); unpack8(rp[mm], p0, p1);
                        f32x4 ga = m0 * (w0a * fm) + c0 * w1a + p0 * (w2a * fp_) + ba, gb = m1 * (w0b * fm) + c1 * w1b + p1 * (w2b * fp_) + bb;
#pragma unroll
                        for (int i = 0; i < 4; ++i) { ga[i] = gelu_tanh(ga[i]) * v0[i]; gb[i] = gelu_tanh(gb[i]) * v1[i]; }
                        *(u32x4*)(O + (size_t)row * FF + col) = pack8(ga, gb);
                    }
                    asm volatile("" ::: "memory");
                }
            }
        }
    }
};
struct EpiPle {
    static constexpr bool PERM = true, AFTER_DRAIN = false;
    const hf* pp; float* x; float* xo;
    __device__ __forceinline__ void operator()(const Acc& acc, const Unit& u, int wr, int wc, int fr, int fq) const {
#pragma unroll
        for (int bj = 0; bj < 2; ++bj) {
            const int col = u.pn * BM + bj * HALF + wc * 32 + 8 * fq;
#pragma unroll
            for (int ai = 0; ai < 2; ++ai) {
                f32x4 xa[4], xb[4]; u32x4 pr[4];
#pragma unroll
                for (int m = 0; m < 4; ++m) { const size_t o = (size_t)(u.pm * BM + ai * HALF + wr * 64 + m * 16 + fr) * D + col;
                    xa[m] = *(const f32x4*)(x + o); xb[m] = *(const f32x4*)(x + o + 4); pr[m] = *(const u32x4*)(pp + o); }
                asm volatile("" ::: "memory");
#pragma unroll
                for (int m = 0; m < 4; ++m) { const size_t o = (size_t)(u.pm * BM + ai * HALF + wr * 64 + m * 16 + fr) * D + col;
                    f32x4 p0, p1; unpack8(pr[m], p0, p1); f32x4 a = xa[m], b2 = xb[m]; const f32x4 v0 = acc[ai][bj][m][0], v1 = acc[ai][bj][m][1];
#pragma unroll
                    for (int i = 0; i < 4; ++i) { a[i] += sigmoidf_(v0[i]) * p0[i]; b2[i] += sigmoidf_(v1[i]) * p1[i]; }
                    *(f32x4*)(xo + o) = a; *(f32x4*)(xo + o + 4) = b2; }
                asm volatile("" ::: "memory");
            }
        }
    }
};

template <class Epi, class Sched>
__device__ __forceinline__ void gemm_phase(PG8_LAS unsigned char* lds, const Gemm g, const Sched& S, const Epi& E, int tid_in) {
    int tid_l = tid_in; asm volatile("" : "+v"(tid_l));
    const int tid = tid_l, wid = __builtin_amdgcn_readfirstlane(tid >> 6), lane = tid & 63, wr = wid >> 2, wc = wid & 3, fr = lane & 15, fq = lane >> 4;
    const int K = g.K, nt = K / BK;
    unsigned voffA[2], voffB[2];
#pragma unroll
    for (int i = 0; i < 2; ++i) { int R, C; stage_rc(tid * 16 + i * 8192, R, C); const int Rb = Epi::PERM ? ((R & ~31) + perm32(R & 31)) : R;
        voffA[i] = (unsigned)(R * K + C) * 2u; voffB[i] = (unsigned)(Rb * K + C) * 2u; }
    const size_t kstep = (size_t)(BK * 2);
    const size_t hstep = (size_t)HALF * K * 2;
    const size_t tstep = 2 * hstep;
    const unsigned ldsw = (unsigned)wid * 1024u;
    const int aoff = lds_byte(wr * 64 + fr, fq * 8), boff = lds_byte(wc * 32 + fr, fq * 8);
#define PG8_SA(b, h) (((b) * 2 + (h)) * HTB)
#define PG8_SB(b, h) ((4 + (b) * 2 + (h)) * HTB)
#define PG8_STAGE(bufoff, gbase, voff) do { _Pragma("unroll") for (int _i = 0; _i < 2; ++_i) \
        __builtin_amdgcn_global_load_lds((const unsigned*)((const char*)(gbase) + (voff)[_i]), (PG8_LAS unsigned*)(lds + (bufoff) + ldsw + _i * 8192), 16, 0, 0); } while (0)
#define PG8_LDA(dst, b, h) do { _Pragma("unroll") for (int m = 0; m < 4; ++m) _Pragma("unroll") for (int k = 0; k < 2; ++k) dst[m][k] = *(const PG8_LAS bf16x8*)(lds + PG8_SA(b, h) + aoff + m * 2048 + k * 1024); } while (0)
#define PG8_LDB(dst, b, h) do { _Pragma("unroll") for (int n = 0; n < 2; ++n) _Pragma("unroll") for (int k = 0; k < 2; ++k) dst[n][k] = *(const PG8_LAS bf16x8*)(lds + PG8_SB(b, h) + boff + n * 2048 + k * 1024); } while (0)
#define PG8_MMA(ai, bj, At, Bt) do { __builtin_amdgcn_s_setprio(1); _Pragma("unroll") for (int m = 0; m < 4; ++m) _Pragma("unroll") for (int n = 0; n < 2; ++n) _Pragma("unroll") for (int k = 0; k < 2; ++k) \
        acc[ai][bj][m][n] = __builtin_amdgcn_mfma_f32_16x16x32_f16(__builtin_bit_cast(hf8, Bt[n][k]), __builtin_bit_cast(hf8, At[m][k]), acc[ai][bj][m][n], 0, 0, 0); __builtin_amdgcn_s_setprio(0); } while (0)
#define PG8_WAIT_V(n) asm volatile("s_waitcnt vmcnt(" #n ")" ::: "memory")
#define PG8_WAIT_L(n) asm volatile("s_waitcnt lgkmcnt(" #n ")" ::: "memory")
#define PG8_BAR __builtin_amdgcn_s_barrier()
#define PG8_SCHED __builtin_amdgcn_sched_barrier(0)
    Unit cur, nxt; int ui = 0;
    if (!S.next(0, cur)) return;
    f32x4 acc[2][2][4][2];
#pragma unroll
    for (int a = 0; a < 2; ++a)
#pragma unroll
        for (int b = 0; b < 2; ++b)
#pragma unroll
            for (int m = 0; m < 4; ++m)
#pragma unroll
                for (int n = 0; n < 2; ++n) acc[a][b][m][n] = (f32x4){0.f, 0.f, 0.f, 0.f};
    bf16x8 At[4][2], B0[2][2], B1[2][2];
    const char* cA = (const char*)g.A + (size_t)cur.pm * tstep; const char* cB = (const char*)g.Bt + (size_t)cur.pn * tstep;
    S.a_ready(cur);
    PG8_STAGE(PG8_SB(0, 0), cB, voffB); PG8_STAGE(PG8_SA(0, 0), cA, voffA); PG8_STAGE(PG8_SB(0, 1), cB + hstep, voffB); PG8_STAGE(PG8_SA(0, 1), cA + hstep, voffA);
    if (wr == 1) PG8_BAR;
    PG8_WAIT_V(4); PG8_BAR;
    PG8_STAGE(PG8_SB(1, 0), cB + kstep, voffB); PG8_STAGE(PG8_SA(1, 0), cA + kstep, voffA); PG8_STAGE(PG8_SB(1, 1), cB + hstep + kstep, voffB);
    PG8_WAIT_V(6); PG8_BAR;
    for (;;) {
        const bool has_next = S.next(ui + 1, nxt);
        const char* nA = has_next ? (const char*)g.A + (size_t)nxt.pm * tstep : cA; const char* nB = has_next ? (const char*)g.Bt + (size_t)nxt.pn * tstep : cB;
        for (int t = 0; t < nt; t += 2) {
            const bool last = (t == nt - 2);
            const char* a1 = cA + (size_t)(t + 1) * kstep;
            const char* a2 = last ? nA : cA + (size_t)(t + 2) * kstep; const char* b2 = last ? nB : cB + (size_t)(t + 2) * kstep;
            const char* a3 = a2 + kstep; const char* b3 = b2 + kstep;
            if (last && has_next) S.a_ready(nxt);
            PG8_LDB(B0, 0, 0); PG8_SCHED; PG8_LDA(At, 0, 0); PG8_STAGE(PG8_SA(1, 1), a1 + hstep, voffA);
            PG8_WAIT_L(8); PG8_BAR; PG8_WAIT_L(0); PG8_MMA(0, 0, At, B0); PG8_BAR; PG8_SCHED;
            PG8_LDB(B1, 0, 1); PG8_STAGE(PG8_SB(0, 0), b2, voffB);
            PG8_BAR; PG8_WAIT_L(0); PG8_MMA(0, 1, At, B1); PG8_BAR;
            PG8_LDA(At, 0, 1); PG8_STAGE(PG8_SA(0, 0), a2, voffA);
            PG8_BAR; PG8_WAIT_L(0); PG8_MMA(1, 0, At, B0); PG8_BAR; PG8_SCHED;
            PG8_STAGE(PG8_SB(0, 1), b2 + hstep, voffB);
            PG8_WAIT_V(6); PG8_BAR; PG8_MMA(1, 1, At, B1); PG8_BAR;
            PG8_LDB(B0, 1, 0); PG8_SCHED; PG8_LDA(At, 1, 0); PG8_STAGE(PG8_SA(0, 1), a2 + hstep, voffA);
            PG8_WAIT_L(8); PG8_BAR; PG8_WAIT_L(0); PG8_MMA(0, 0, At, B0); PG8_BAR; PG8_SCHED;
            PG8_LDB(B1, 1, 1); PG8_STAGE(PG8_SB(1, 0), b3, voffB);
            PG8_BAR; PG8_WAIT_L(0); PG8_MMA(0, 1, At, B1); PG8_BAR;
            PG8_LDA(At, 1, 1); PG8_STAGE(PG8_SA(1, 0), a3, voffA);
            PG8_BAR; PG8_WAIT_L(0); PG8_MMA(1, 0, At, B0); PG8_BAR; PG8_SCHED;
            PG8_STAGE(PG8_SB(1, 1), b3 + hstep, voffB);
            PG8_WAIT_V(6); PG8_BAR; PG8_MMA(1, 1, At, B1); PG8_BAR;
        }
        if constexpr (!Epi::AFTER_DRAIN) { E(acc, cur, wr, wc, fr, fq); S.done(cur); }
        if (!has_next) break;
#pragma unroll
        for (int a = 0; a < 2; ++a)
#pragma unroll
            for (int b = 0; b < 2; ++b)
#pragma unroll
                for (int m = 0; m < 4; ++m)
#pragma unroll
                    for (int n = 0; n < 2; ++n) acc[a][b][m][n] = (f32x4){0.f, 0.f, 0.f, 0.f};
        cur = nxt; cA = nA; cB = nB; ++ui;
    }
    PG8_WAIT_V(0);
    if (wr == 0) PG8_BAR;
    PG8_BAR;
    if constexpr (Epi::AFTER_DRAIN) { E.fused(acc, cur, wr, wc, fr, fq, lds, wid, lane); S.done(cur); }
#undef PG8_SA
#undef PG8_SB
#undef PG8_STAGE
#undef PG8_LDA
#undef PG8_LDB
#undef PG8_MMA
#undef PG8_WAIT_V
#undef PG8_WAIT_L
#undef PG8_BAR
#undef PG8_SCHED
}
}
struct Params {
    const float* in[30];
    float* out; unsigned char* ws;
    int ph_lo, ph_hi;
};
enum { I_X = 0, I_P, I_NORM_MIX, I_W_IN, I_RW_MU, I_RW_W0, I_RW_W2, I_RW_A0, I_RW_A2, I_RW_G2, I_RW_KK, I_RW_KA, I_RW_RK, I_RW_LNG, I_RW_LNB, I_NA_BIAS,
       I_W_BRA, I_W_BRB, I_W_BRC, I_W_OUT, I_NORM_FFN, I_W_FG, I_W_FU, I_CONV_W, I_CONV_B, I_W_FD, I_NORM_PLE, I_W_PG, I_W_PLE, I_NORM_FINAL };

struct Ctx { LAS unsigned char* lds; int tid, lane, wave, G, gw, NGW, bid; };

#define LDS_WAIT() asm volatile("s_waitcnt lgkmcnt(0)" ::: "memory")

__device__ __forceinline__ void transpose_item(const float* W, int K, int N, hf* WT, int k0, int n0, int drow0, LAS float* scr, int lane) {
#pragma unroll 8
    for (int i = 0; i < 32; ++i) { const int kk = 2 * i + (lane >> 5); scr[kk * 33 + (lane & 31)] = W[(size_t)(k0 + kk) * N + n0 + (lane & 31)]; }
    LDS_WAIT();
    const int c = lane & 7;
#pragma unroll
    for (int j = 0; j < 4; ++j) { const int n = (lane >> 3) + 8 * j; const LAS float* s = scr + (8 * c) * 33 + n;
        u32x4 o; o.x = pkh(s[0 * 33], s[1 * 33]); o.y = pkh(s[2 * 33], s[3 * 33]); o.z = pkh(s[4 * 33], s[5 * 33]); o.w = pkh(s[6 * 33], s[7 * 33]);
        *(u32x4*)(WT + (size_t)(drow0 + n) * K + k0 + 8 * c) = o; }
    LDS_WAIT();
}
__device__ __forceinline__ bool conv_one(int& r, const float* W, int K, int N, hf* WT, LAS float* scr, int lane, bool remap, int nb0 = 0, int nb1 = 1 << 30) {
    const int nblk_all = N / 32, nblk = (nb1 < nblk_all ? nb1 : nblk_all) - nb0, items = (K / 64) * nblk;
    if (r >= items) { r -= items; return false; }
    const int kb = r / nblk, nb = nb0 + r % nblk, n0 = 32 * nb;
    int dr = n0;
    if (remap) dr = n0 < RW_COLS ? n0 : (n0 < RW_COLS + QKVW ? n0 - RW_COLS + RWP : n0 - (RW_COLS + QKVW) + NIN1);
    transpose_item(W, K, N, WT, 64 * kb, n0, dr, scr, lane);
    return true;
}
__device__ __forceinline__ void phase_convert_part(const Params& P, const Ctx& C, int li, int part, int gw, int ngw, int i0 = 0, int i1 = 1 << 30) {
    unsigned char* ws = P.ws;
    LAS float* scr = (LAS float*)(C.lds + C.wave * 16384);
    if (part == 0) {
        constexpr int NITEMS = 32 * 199 + 512 + 256 + 768 + 2048;
        for (int it = i0 + gw; it < (i1 < NITEMS ? i1 : NITEMS); it += ngw) {
            int r = it;
            if (conv_one(r, P.in[I_W_IN] + (size_t)li * D * IN_COLS, D, IN_COLS, (hf*)(ws + WS_WIN), scr, C.lane, true, 0, 199)) continue;
            if (conv_one(r, P.in[I_W_BRA] + (size_t)li * 512 * D, 512, D, (hf*)(ws + WS_WA), scr, C.lane, false)) continue;
            if (conv_one(r, P.in[I_W_BRB] + (size_t)li * 256 * D, 256, D, (hf*)(ws + WS_WB), scr, C.lane, false)) continue;
            if (conv_one(r, P.in[I_W_BRC] + (size_t)li * 768 * D, 768, D, (hf*)(ws + WS_WC), scr, C.lane, false)) continue;
            conv_one(r, P.in[I_W_OUT] + (size_t)li * D * D, D, D, (hf*)(ws + WS_WO), scr, C.lane, false);
        }
    } else if (part == 2) {
        constexpr int NITEMS = 32 * 192;
        for (int it = i0 + gw; it < (i1 < NITEMS ? i1 : NITEMS); it += ngw) { int r = it; conv_one(r, P.in[I_W_IN] + (size_t)li * D * IN_COLS, D, IN_COLS, (hf*)(ws + WS_WIN), scr, C.lane, true, 199, 391); }
    } else {
        constexpr int NITEMS = 3 * 5632 + 2048 + 256;
        for (int it = gw; it < NITEMS; it += ngw) {
            int r = it;
            if (conv_one(r, P.in[I_W_FG] + (size_t)li * D * FF, D, FF, (hf*)(ws + WS_WG), scr, C.lane, false)) continue;
            if (conv_one(r, P.in[I_W_FU] + (size_t)li * D * FF, D, FF, (hf*)(ws + WS_WU), scr, C.lane, false)) continue;
            if (conv_one(r, P.in[I_W_FD] + (size_t)li * FF * D, FF, D, (hf*)(ws + WS_WD), scr, C.lane, false)) continue;
            if (conv_one(r, P.in[I_W_PG] + (size_t)li * D * D, D, D, (hf*)(ws + WS_WPG), scr, C.lane, false)) continue;
            conv_one(r, P.in[I_W_PLE] + (size_t)li * PLE * D, PLE, D, (hf*)(ws + WS_WP), scr, C.lane, false);
        }
    }
}
__device__ __forceinline__ void phase_convert(const Params& P, const Ctx& C, int li) {
    unsigned char* ws = P.ws;
    if (!(li == 1 && C.G == 256)) { phase_convert_part(P, C, li, 0, C.gw, C.NGW); phase_convert_part(P, C, li, 2, C.gw, C.NGW); }
    if (li == 0) {
        float* rc = (float*)(ws + WS_ROPE); float* rs = rc + T * 32;
        for (int i = C.bid * NTHR + C.tid; i < T * 32; i += C.G * NTHR) {
            const int t = i >> 5, e = i & 31;
            const float inv = exp2f(-(float)e * 0.41524101186f);
            const float ang = (float)t * inv; float s, c; sincosf(ang, &s, &c); rc[i] = c; rs[i] = s;
        }
        const f32x4* p4 = (const f32x4*)P.in[I_P]; u32x2* o = (u32x2*)(ws + WS_P16);
        for (int i = C.bid * NTHR + C.tid; i < 2 * M * PLE / 4; i += C.G * NTHR) { const f32x4 v = p4[i]; u32x2 w; w.x = pkh(v.x, v.y); w.y = pkh(v.z, v.w); o[i] = w; }
    }
}
__device__ __forceinline__ void phase_norm(const float* xin, const float* gain, hf* hout, const Ctx& C) {
    for (int m = 2 * C.gw; m < M; m += 2 * C.NGW) {
        const f32x4* xr = (const f32x4*)(xin + (size_t)m * D) + C.lane;
        f32x4 v[2][8]; float s0 = 0.f, s1 = 0.f;
#pragma unroll
        for (int j = 0; j < 8; ++j) { v[0][j] = xr[64 * j]; v[1][j] = xr[64 * j + D / 4]; }
#pragma unroll
        for (int j = 0; j < 8; ++j) { s0 += (v[0][j].x * v[0][j].x + v[0][j].y * v[0][j].y) + (v[0][j].z * v[0][j].z + v[0][j].w * v[0][j].w);
                                      s1 += (v[1][j].x * v[1][j].x + v[1][j].y * v[1][j].y) + (v[1][j].z * v[1][j].z + v[1][j].w * v[1][j].w); }
        const float rs0 = rsqrtf(wave_sum(s0, C.lane) * (1.0f / D) + 1e-6f), rs1 = rsqrtf(wave_sum(s1, C.lane) * (1.0f / D) + 1e-6f);
        u32x2* o = (u32x2*)(hout + (size_t)m * D) + C.lane;
#pragma unroll
        for (int j = 0; j < 8; ++j) { const f32x4 g = ((const f32x4*)gain)[C.lane + 64 * j]; const f32x4 r0 = v[0][j] * rs0 * g, r1 = v[1][j] * rs1 * g;
            u32x2 w0, w1; w0.x = pkh(r0.x, r0.y); w0.y = pkh(r0.z, r0.w); w1.x = pkh(r1.x, r1.y); w1.y = pkh(r1.z, r1.w); o[64 * j] = w0; o[64 * j + D / 4] = w1; }
    }
}
__device__ __forceinline__ void phase_final_norm(float* x, const float* gain, const Ctx& C) {
    for (int m = 2 * C.gw; m < M; m += 2 * C.NGW) {
        f32x4* xr = (f32x4*)(x + (size_t)m * D) + C.lane;
        f32x4 v[2][8]; float s0 = 0.f, s1 = 0.f;
#pragma unroll
        for (int j = 0; j < 8; ++j) { v[0][j] = xr[64 * j]; v[1][j] = xr[64 * j + D / 4]; }
#pragma unroll
        for (int j = 0; j < 8; ++j) { s0 += (v[0][j].x * v[0][j].x + v[0][j].y * v[0][j].y) + (v[0][j].z * v[0][j].z + v[0][j].w * v[0][j].w);
                                      s1 += (v[1][j].x * v[1][j].x + v[1][j].y * v[1][j].y) + (v[1][j].z * v[1][j].z + v[1][j].w * v[1][j].w); }
        const float rs0 = rsqrtf(wave_sum(s0, C.lane) * (1.0f / D) + 1e-6f), rs1 = rsqrtf(wave_sum(s1, C.lane) * (1.0f / D) + 1e-6f);
#pragma unroll
        for (int j = 0; j < 8; ++j) { const f32x4 g = ((const f32x4*)gain)[C.lane + 64 * j]; xr[64 * j] = v[0][j] * rs0 * g; xr[64 * j + D / 4] = v[1][j] * rs1 * g; }
    }
}

constexpr int TT = 16;
__device__ __forceinline__ void phase_rwkv_pre(const Params& P, const Ctx& C, int li) {
    unsigned char* ws = P.ws;
    const float* RW = (const float*)(ws + Z_RWBUF);
    LAS float* cs = (LAS float*)C.lds;
    const float* mu = P.in[I_RW_MU] + li * RW_COLS;
    const float* w0 = P.in[I_RW_W0] + li * 1024; const float* w2 = P.in[I_RW_W2] + (size_t)li * 2 * 32 * 512;
    const float* a0 = P.in[I_RW_A0] + li * 1024; const float* a2 = P.in[I_RW_A2] + (size_t)li * 2 * 32 * 512;
    const int c = C.tid, h = C.wave, e = C.lane;
    const float kkc = P.in[I_RW_KK][li * 512 + c], kac = P.in[I_RW_KA][li * 512 + c], rkc = P.in[I_RW_RK][li * 512 + c];
    const float w00 = w0[c], w01 = w0[512 + c], a00 = a0[c], a01 = a0[512 + c];
    hf* S1 = (hf*)(ws + Z_S1); hf* S2 = (hf*)(ws + Z_S2); hf* SG = (hf*)(ws + Z_SG); hf* BON = (hf*)(ws + Z_BONUS);
    for (int tl = C.bid; tl < M / TT; tl += C.G) {
        const int m0 = tl * TT;
        for (int base = 0; base < TT * 440; base += 2 * NTHR) {
            f32x4 x0[2], xm[2], xp[2], mu4[2]; float fm[2], fp_[2]; int idxs[2];
#pragma unroll
            for (int u = 0; u < 2; ++u) {
                const int idx = min(base + u * NTHR + C.tid, TT * 440 - 1); idxs[u] = idx;
                const int tt = idx / 440, c4 = idx - tt * 440, m = m0 + tt, t = m & (T - 1);
                const float* p = RW + (size_t)m * RWP + 4 * c4;
                x0[u] = *(const f32x4*)p; xm[u] = *(const f32x4*)(t > 0 ? p - RWP : p); xp[u] = *(const f32x4*)(t < T - 1 ? p + RWP : p); mu4[u] = *(const f32x4*)(mu + 4 * c4);
                fm[u] = t > 0 ? 0.5f : 0.0f; fp_[u] = t < T - 1 ? 0.5f : 0.0f;
            }
            asm volatile("" ::: "memory");
#pragma unroll
            for (int u = 0; u < 2; ++u) if (base + u * NTHR + C.tid < TT * 440) {
                const int idx = idxs[u], tt = idx / 440, c4 = idx - tt * 440;
                f32x4 v = x0[u] + mu4[u] * ((xm[u] * fm[u] + xp[u] * fp_[u]) - x0[u]);
                if (c4 >= 384 && c4 < 400) { v.x = tanhf(v.x); v.y = tanhf(v.y); v.z = tanhf(v.z); v.w = tanhf(v.w); }
                else if (c4 >= 416) { v.x = sigmoidf_(v.x); v.y = sigmoidf_(v.y); v.z = sigmoidf_(v.z); v.w = sigmoidf_(v.w); }
                *(LAS f32x4*)(cs + tt * RW_COLS + 4 * c4) = v;
            }
        }
        __syncthreads();
        float zw0[TT], zw1[TT], za0[TT], za1[TT];
#pragma unroll
        for (int tt = 0; tt < TT; ++tt) { zw0[tt] = w00; zw1[tt] = w01; za0[tt] = a00; za1[tt] = a01; }
#pragma unroll 2
        for (int l0 = 0; l0 < 32; l0 += 4) {
            float ww0[4], ww1[4], aa0[4], aa1[4];
#pragma unroll
            for (int i = 0; i < 4; ++i) { ww0[i] = w2[(l0 + i) * 512 + c]; ww1[i] = w2[(32 + l0 + i) * 512 + c]; aa0[i] = a2[(l0 + i) * 512 + c]; aa1[i] = a2[(32 + l0 + i) * 512 + c]; }
#pragma unroll
            for (int tt = 0; tt < TT; ++tt) {
                const LAS float* q = cs + tt * RW_COLS;
                const f32x4 t0 = *(const LAS f32x4*)(q + 1536 + l0), t1 = *(const LAS f32x4*)(q + 1568 + l0), u0 = *(const LAS f32x4*)(q + 1600 + l0), u1 = *(const LAS f32x4*)(q + 1632 + l0);
#pragma unroll
                for (int i = 0; i < 4; ++i) { zw0[tt] += t0[i] * ww0[i]; zw1[tt] += t1[i] * ww1[i]; za0[tt] += u0[i] * aa0[i]; za1[tt] += u1[i] * aa1[i]; }
            }
        }
        for (int idx = C.tid; idx < TT * 96; idx += NTHR) { const int tt = idx / 96, l = idx - tt * 96; SG[(size_t)(m0 + tt) * 96 + l] = (hf)cs[tt * RW_COLS + 1664 + l]; }
#pragma unroll
        for (int tt = 0; tt < TT; ++tt) {
            const int m = m0 + tt, b = m >> 12, t = m & (T - 1);
            const LAS float* q = cs + tt * RW_COLS;
            const float r = q[c], k = q[512 + c], v = q[1024 + c];
            const float ld0 = -0.60653066f * 1.44269504f * sigmoidf_(zw0[tt]), ld1 = -0.60653066f * 1.44269504f * sigmoidf_(zw1[tt]);
            const float lr0 = sigmoidf_(za0[tt]), lr1 = sigmoidf_(za1[tt]);
            const float kkv = k * kkc;
            const float nrm = sqrtf(wave_sum(kkv * kkv, C.lane));
            const float kk = kkv / fmaxf(nrm, 1e-12f);
            const float kd0 = k * (1.0f + (lr0 - 1.0f) * kac), kd1 = k * (1.0f + (lr1 - 1.0f) * kac);
            const float bon = (wave_sum(r * kd0 * rkc, C.lane) + wave_sum(r * kd1 * rkc, C.lane)) * v;
            hf* s1 = S1 + ((size_t)(b * 8 + h) * T + t) * 192 + e;
            s1[0] = (hf)r; s1[64] = (hf)(-kk); s1[128] = (hf)v;
            hf* s20 = S2 + ((size_t)((0 * 4 + b) * 8 + h) * T + t) * 192 + e;
            hf* s21 = S2 + ((size_t)((1 * 4 + b) * 8 + h) * T + t) * 192 + e;
            s20[0] = (hf)ld0; s20[64] = (hf)kd0; s20[128] = (hf)(kk * lr0);
            s21[0] = (hf)ld1; s21[64] = (hf)kd1; s21[128] = (hf)(kk * lr1);
            BON[(size_t)m * 512 + c] = (hf)bon;
        }
        __syncthreads();
    }
}
__device__ __forceinline__ void phase_rope(const Params& P, const Ctx& C) {
    unsigned char* ws = P.ws;
    hf* QKV = (hf*)(ws + Z_QKV);
    const float* rc = (const float*)(ws + WS_ROPE); const float* rs = rc + T * 32;
    for (int i = C.bid * NTHR + C.tid; i < M * 2 * 12 * 4; i += C.G * NTHR) {
        const int c8 = i & 3, hh = (i >> 2) % 12, rest = (i >> 2) / 12, which = rest & 1, m = rest >> 1, t = m & (T - 1);
        hf* p = QKV + (size_t)m * QKVW + which * 768 + hh * 64 + 8 * c8;
        f32x4 a0_, a1_, b0_, b1_; unpack8(*(const u32x4*)p, a0_, a1_); unpack8(*(const u32x4*)(p + 32), b0_, b1_);
        const f32x4 c0 = *(const f32x4*)(rc + t * 32 + 8 * c8), c1 = *(const f32x4*)(rc + t * 32 + 8 * c8 + 4), s0 = *(const f32x4*)(rs + t * 32 + 8 * c8), s1 = *(const f32x4*)(rs + t * 32 + 8 * c8 + 4);
        const float sc = which == 0 ? 0.125f : 1.0f;
        const f32x4 o0 = (a0_ * c0 - b0_ * s0) * sc, o1 = (a1_ * c1 - b1_ * s1) * sc, o2 = (b0_ * c0 + a0_ * s0) * sc, o3 = (b1_ * c1 + a1_ * s1) * sc;
        *(u32x4*)p = pack8(o0, o1); *(u32x4*)(p + 32) = pack8(o2, o3);
    }
}

__device__ __forceinline__ void phase_gate_lora(const Params& P, const Ctx& C, int li, int wg, int nwg) {
    unsigned char* ws = P.ws;
    const hf* SG = (const hf*)(ws + Z_SG); hf* GRW = (hf*)(ws + Z_GRW);
    const float* g2 = P.in[I_RW_G2] + (size_t)li * 96 * 512;
    LAS float* sg = (LAS float*)C.lds;
    const int c0 = C.tid & 255, th = C.tid >> 8;
    __syncthreads();
    for (int tl = wg; tl < M / 32; tl += nwg) {
        const int m0 = tl * 32;
        if (C.tid < 32 * 96 / 8) {
            f32x4 a, b; unpack8(*(const u32x4*)(SG + (size_t)m0 * 96 + 8 * C.tid), a, b);
            *(LAS f32x4*)(sg + 8 * C.tid) = a; *(LAS f32x4*)(sg + 8 * C.tid + 4) = b;
        }
        __syncthreads();
        float acc0[16], acc1[16];
#pragma unroll
        for (int tt = 0; tt < 16; ++tt) { acc0[tt] = 0.f; acc1[tt] = 0.f; }
#pragma unroll 2
        for (int l0 = 0; l0 < 96; l0 += 4) {
            float g0[4], g1[4];
#pragma unroll
            for (int i = 0; i < 4; ++i) { g0[i] = g2[(l0 + i) * 512 + c0]; g1[i] = g2[(l0 + i) * 512 + c0 + 256]; }
#pragma unroll
            for (int tt = 0; tt < 16; ++tt) { const f32x4 sv = *(const LAS f32x4*)(sg + (16 * th + tt) * 96 + l0);
#pragma unroll
                for (int i = 0; i < 4; ++i) { acc0[tt] += sv[i] * g0[i]; acc1[tt] += sv[i] * g1[i]; } }
        }
#pragma unroll
        for (int tt = 0; tt < 16; ++tt) { hf* o = GRW + (size_t)(m0 + 16 * th + tt) * 512 + c0; o[0] = (hf)acc0[tt]; o[256] = (hf)acc1[tt]; }
        __syncthreads();
    }
}

constexpr int SB = 16, SSTEP = 352;
__device__ __forceinline__ void scan_load(const hf* s1, const hf* s2, int d, int n, int lt, u32x4 (&reg)[3]) {
#pragma unroll
    for (int j = 0; j < 3; ++j) {
        const int id = lt + 256 * j, s = id / 48, cc = id - s * 48, sa = SB * n + s, t = d ? (T - 1 - sa) : sa;
        const hf* src = cc < 24 ? (s1 + (size_t)t * 192 + cc * 8) : (s2 + (size_t)t * 192 + (cc - 24) * 8);
        reg[j] = *(const u32x4*)src;
    }
}
__device__ __forceinline__ void scan_store(LAS float* buf, int i0, int lt, const u32x4 (&reg)[3]) {
#pragma unroll
    for (int j = 0; j < 3; ++j) {
        const int id = lt + 256 * j, s = id / 48, cc = id - s * 48;
        f32x4 a, b; unpack8(reg[j], a, b);
        int dst;
        if (cc < 24) { const int arr = cc >> 3, e0 = (cc & 7) * 8;
            if (arr == 0) dst = 192 + e0; else if (arr == 1) dst = 256 + e0; else dst = (e0 >= i0 && e0 < i0 + 32) ? 320 + (e0 - i0) : -1;
        } else { const int c2 = cc - 24, arr = c2 >> 3, e0 = (c2 & 7) * 8;
            if (arr == 0) { dst = e0;
#pragma unroll
                for (int i = 0; i < 4; ++i) { a[i] = __builtin_amdgcn_exp2f(a[i]); b[i] = __builtin_amdgcn_exp2f(b[i]); } }
            else if (arr == 1) dst = 64 + e0; else dst = 128 + e0;
        }
        if (dst >= 0) { LAS float* q = buf + s * SSTEP + dst; *(LAS f32x4*)q = a; *(LAS f32x4*)(q + 4) = b; }
    }
}
__device__ __forceinline__ float dot4(const f32x4 S, const f32x4 a) { f32x2 p = (f32x2){S.x, S.y} * (f32x2){a.x, a.y}; p = (f32x2){S.z, S.w} * (f32x2){a.z, a.w} + p; return p.x + p.y; }
__device__ __forceinline__ float dpp_f(float x, int ctrl_sel) {
    const int xi = __builtin_bit_cast(int, x); int r;
    if (ctrl_sel == 0) r = __builtin_amdgcn_update_dpp(0, xi, 0x140, 0xF, 0xF, false);
    else if (ctrl_sel == 1) r = __builtin_amdgcn_update_dpp(0, xi, 0x141, 0xF, 0xF, false);
    else if (ctrl_sel == 2) r = __builtin_amdgcn_update_dpp(0, xi, 0x1B, 0xF, 0xF, false);
    else r = __builtin_amdgcn_update_dpp(0, xi, 0xB1, 0xF, 0xF, false);
    return __builtin_bit_cast(float, r);
}
__device__ __forceinline__ float rs16(const float (&p)[16], int lane) {
    const bool b3 = lane & 8, b2 = lane & 4, b1 = lane & 2, b0 = lane & 1;
    float q[8], r[4], u[2];
#pragma unroll
    for (int i = 0; i < 8; ++i) { const float keep = b3 ? p[i + 8] : p[i], send = b3 ? p[i] : p[i + 8]; q[i] = keep + dpp_f(send, 0); }
#pragma unroll
    for (int i = 0; i < 4; ++i) { const float keep = b2 ? q[i + 4] : q[i], send = b2 ? q[i] : q[i + 4]; r[i] = keep + dpp_f(send, 1); }
#pragma unroll
    for (int i = 0; i < 2; ++i) { const float keep = b1 ? r[i + 2] : r[i], send = b1 ? r[i] : r[i + 2]; u[i] = keep + dpp_f(send, 2); }
    const float keep = b0 ? u[1] : u[0], send = b0 ? u[0] : u[1];
    return keep + dpp_f(send, 3);
}
__device__ __forceinline__ void phase_scan(const Params& P, const Ctx& C, int nscan) {
    unsigned char* ws = P.ws;
    LAS float* buf = (LAS float*)C.lds;
    for (int item = C.bid; item < 128; item += nscan) {
        const int chain = item >> 1, hf_ = item & 1, d = chain >> 5, b = (chain >> 3) & 3, h = chain & 7, i0 = 32 * hf_;
        const hf* s1 = (const hf*)(ws + Z_S1) + (size_t)(b * 8 + h) * T * 192;
        const hf* s2 = (const hf*)(ws + Z_S2) + (size_t)((d * 4 + b) * 8 + h) * T * 192;
        float* yout = (float*)(ws + (d ? Z_YBK : Z_YF)) + (size_t)b * T * 512 + h * 64 + i0;
        const bool loader = C.wave >= 4;
        const int lt = C.tid - 256;
        u32x4 reg[3];
        if (loader) { scan_load(s1, s2, d, 0, lt, reg); scan_store(buf, i0, lt, reg); scan_load(s1, s2, d, 1, lt, reg); }
        __syncthreads();
        const int rowA = 8 * C.wave + (C.lane >> 4), rowB = rowA + 4, col0 = 4 * (C.lane & 15);
        f32x4 SA = {0.f, 0.f, 0.f, 0.f}, SBs = SA;
        for (int n = 0; n < T / SB; ++n) {
            if (loader) {
                if (n + 1 < T / SB) scan_store(buf + ((n + 1) & 1) * (SB * SSTEP), i0, lt, reg);
                if (n + 2 < T / SB) scan_load(s1, s2, d, n + 2, lt, reg);
            } else {
                const LAS float* bb = buf + (n & 1) * (SB * SSTEP);
                f32x4 w = *(const LAS f32x4*)(bb + col0), kd = *(const LAS f32x4*)(bb + 64 + col0), bv = *(const LAS f32x4*)(bb + 128 + col0),
                      r = *(const LAS f32x4*)(bb + 192 + col0), a = *(const LAS f32x4*)(bb + 256 + col0);
                float vA = bb[320 + rowA], vB = bb[320 + rowB];
                float pA[SB], pB[SB];
#pragma unroll
                for (int s = 0; s < SB; ++s) {
                    f32x4 nw = w, nkd = kd, nbv = bv, nr = r, na = a; float nvA = vA, nvB = vB;
                    if (s + 1 < SB) {
                        const LAS float* q = bb + (s + 1) * SSTEP;
                        nw = *(const LAS f32x4*)(q + col0); nkd = *(const LAS f32x4*)(q + 64 + col0); nbv = *(const LAS f32x4*)(q + 128 + col0);
                        nr = *(const LAS f32x4*)(q + 192 + col0); na = *(const LAS f32x4*)(q + 256 + col0); nvA = q[320 + rowA]; nvB = q[320 + rowB];
                    }
                    float saA = dot4(SA, a), saB = dot4(SBs, a);
                    saA = dpp_allsum16(saA); saB = dpp_allsum16(saB);
                    SA = SA * w + saA * bv + vA * kd; SBs = SBs * w + saB * bv + vB * kd;
                    pA[s] = dot4(SA, r); pB[s] = dot4(SBs, r);
                    w = nw; kd = nkd; bv = nbv; r = nr; a = na; vA = nvA; vB = nvB;
                }
                {
                    const float yA = rs16(pA, C.lane), yB = rs16(pB, C.lane);
                    const int sabs = SB * n + (C.lane & 15), t = d ? (T - 1 - sabs) : sabs;
                    yout[(size_t)t * 512 + rowA] = yA; yout[(size_t)t * 512 + rowB] = yB;
                }
            }
            __syncthreads();
        }
    }
}

__device__ __forceinline__ hf8 ld_h8(const hf* p) { return __builtin_bit_cast(hf8, *(const u32x4*)p); }
template <int NT, bool NA>
__device__ __forceinline__ void attn_item(const Params& P, int li, int idx, int lane, LAS unsigned char* vbuf) {
    unsigned char* ws = P.ws;
    const hf* QKV = (const hf*)(ws + Z_QKV);
    const int ql = lane & 15, g = lane >> 4;
    int b, head, tok_q, qoff, koff, voff;
    int ldil = 0, res = 0, nsub = 0, jq0 = 0, k0 = 0, grp = 0;
    int r = 0, cb = 0, r0 = 0, kc0 = 0, qc = 0, wc0 = 0;
    if (!NA) {
        const int qi = idx & 255; head = (idx >> 8) % 12; b = idx / (256 * 12);
        grp = head >> 2; ldil = 2 * grp; nsub = T >> ldil;
        const int per = nsub >> 4;
        res = qi / per; jq0 = (qi - res * per) * 16; k0 = jq0 - 64;
        tok_q = b * T + ((jq0 + ql) << ldil) + res;
        qoff = head * 64; koff = 768 + head * 64; voff = 1536 + head * 64;
    } else {
        cb = idx & 3; r = (idx >> 2) & 63; head = (idx >> 8) % 12; b = idx / (256 * 12);
        qc = 16 * cb + ql; tok_q = b * T + r * 64 + qc;
        r0 = min(max(r - 4, 0), 56); kc0 = min(max(16 * cb - 8, 0), 32); wc0 = min(max(qc - 8, 0), 48);
        qoff = 2304 + head * 64; koff = 3072 + head * 64; voff = 3840 + head * 64;
    }
    auto ktok = [&](int tl, int kin) -> int {
        if (!NA) { int jk = k0 + 16 * tl + kin; jk = min(max(jk, 0), nsub - 1); return b * T + (jk << ldil) + res; }
        else return b * T + (r0 + (tl >> 1)) * 64 + kc0 + 16 * (tl & 1) + kin;
    };
    const hf* qp = QKV + (size_t)tok_q * QKVW + qoff + 8 * g;
    const hf8 q0 = ld_h8(qp), q1 = ld_h8(qp + 32);
    f32x4 sc[NT];
    constexpr int KB = NT >= 16 ? 8 : NT;
#pragma unroll
    for (int t0 = 0; t0 < NT; t0 += KB) {
        hf8 kfa[KB], kfb[KB];
#pragma unroll
        for (int i = 0; i < KB; ++i) { const hf* kp = QKV + (size_t)ktok(t0 + i, ql) * QKVW + koff + 8 * g; kfa[i] = ld_h8(kp); kfb[i] = ld_h8(kp + 32); }
        asm volatile("" ::: "memory");
#pragma unroll
        for (int i = 0; i < KB; ++i) {
            f32x4 a = {0.f, 0.f, 0.f, 0.f};
            a = __builtin_amdgcn_mfma_f32_16x16x32_f16(kfa[i], q0, a, 0, 0, 0);
            a = __builtin_amdgcn_mfma_f32_16x16x32_f16(kfb[i], q1, a, 0, 0, 0);
            sc[t0 + i] = a;
        }
    }
    const float* bias = P.in[I_NA_BIAS] + ((size_t)li * 12 + head) * 15 * 31;
    float mx = -3.0e38f;
#pragma unroll
    for (int tl = 0; tl < NT; ++tl)
#pragma unroll
        for (int j = 0; j < 4; ++j) {
            float s = sc[tl][j]; bool ok;
            if (!NA) { const int jk = k0 + 16 * tl + 4 * g + j, dq = jk - (jq0 + ql); ok = (dq <= 64) && (dq >= -64) && (jk >= 0) && (jk < nsub); }
            else { const int kc = kc0 + 16 * (tl & 1) + 4 * g + j, dy = r0 + (tl >> 1) - r, dxi = min(max(kc - qc, -15), 15) + 15;
                   s = s * 0.125f + bias[(dy + 7) * 31 + dxi]; ok = (kc >= wc0) && (kc < wc0 + 16); }
            s = ok ? s : -1.0e30f; sc[tl][j] = s; mx = fmaxf(mx, s);
        }
    mx = fmaxf(mx, xor_shfl(mx, lane, 16)); mx = fmaxf(mx, xor_shfl(mx, lane, 32));
    float sum = 0.f;
#pragma unroll
    for (int tl = 0; tl < NT; ++tl)
#pragma unroll
        for (int j = 0; j < 4; ++j) { const float p = sc[tl][j] > -1.0e29f ? __expf(sc[tl][j] - mx) : 0.f; sc[tl][j] = p; sum += p; }
    sum += xor_shfl(sum, lane, 16); sum += xor_shfl(sum, lane, 32);
    const float inv = 1.0f / sum;
    f32x4 o[4];
#pragma unroll
    for (int et = 0; et < 4; ++et) o[et] = (f32x4){0.f, 0.f, 0.f, 0.f};
    constexpr int NP = NT / 2, VSTR = 136;
    const int vkey = lane >> 3, vch = lane & 7;
#pragma unroll
    for (int p0 = 0; p0 < NP; p0 += 4) {
        u32x4 vreg[4][4];
#pragma unroll
        for (int pp = 0; pp < 4; ++pp) if (p0 + pp < NP) {
#pragma unroll
            for (int i = 0; i < 4; ++i) { const int key = vkey + 8 * i; vreg[pp][i] = *(const u32x4*)(QKV + (size_t)ktok(2 * (p0 + pp) + (key >> 4), key & 15) * QKVW + voff + 8 * vch); }
        }
#pragma unroll
        for (int pp = 0; pp < 4; ++pp) if (p0 + pp < NP) {
            const int p = p0 + pp;
            hf8 pf;
#pragma unroll
            for (int j = 0; j < 4; ++j) { pf[j] = (hf)sc[2 * p][j]; pf[4 + j] = (hf)sc[2 * p + 1][j]; }
#pragma unroll
            for (int i = 0; i < 4; ++i) { LAS unsigned char* wp = vbuf + (vkey + 8 * i) * VSTR + 16 * vch;
                *(LAS u32x2*)wp = (u32x2){vreg[pp][i].x, vreg[pp][i].y}; *(LAS u32x2*)(wp + 8) = (u32x2){vreg[pp][i].z, vreg[pp][i].w}; }
            asm volatile("" ::: "memory");
#pragma unroll
            for (int et = 0; et < 4; ++et) {
                const LAS unsigned short* rp = (const LAS unsigned short*)(vbuf + (4 * g) * VSTR) + 16 * et + ql;
                u32x4 vv;
                vv.x = (unsigned)rp[0 * (VSTR / 2)] | ((unsigned)rp[1 * (VSTR / 2)] << 16); vv.y = (unsigned)rp[2 * (VSTR / 2)] | ((unsigned)rp[3 * (VSTR / 2)] << 16);
                vv.z = (unsigned)rp[16 * (VSTR / 2)] | ((unsigned)rp[17 * (VSTR / 2)] << 16); vv.w = (unsigned)rp[18 * (VSTR / 2)] | ((unsigned)rp[19 * (VSTR / 2)] << 16);
                o[et] = __builtin_amdgcn_mfma_f32_16x16x32_f16(__builtin_bit_cast(hf8, vv), pf, o[et], 0, 0, 0);
            }
            asm volatile("" ::: "memory");
        }
    }
    hf* op;
    if (!NA) op = (hf*)(ws + Z_DILO) + ((size_t)grp * M + tok_q) * 256 + (head & 3) * 64 + 4 * g;
    else op = (hf*)(ws + Z_YC) + (size_t)tok_q * 768 + head * 64 + 4 * g;
#pragma unroll
    for (int et = 0; et < 4; ++et) { const f32x4 v = o[et] * inv; u32x2 w; w.x = pkh(v.x, v.y); w.y = pkh(v.z, v.w); *(u32x2*)(op + 16 * et) = w; }
    if (!NA && g == 0) ((float*)(ws + Z_LSE))[((size_t)grp * M + tok_q) * 4 + (head & 3)] = mx + __logf(sum);
}
__device__ __forceinline__ void phase_attn(const Params& P, const Ctx& C, int li, int gw, int ngw) {
    constexpr int NITEM = 4 * 12 * 256;
    LAS unsigned char* vbuf = C.lds + C.wave * 16384;
    for (int it = gw; it < NITEM; it += ngw) attn_item<10, false>(P, li, it, C.lane, vbuf);
    for (int it = gw; it < NITEM; it += ngw) attn_item<16, true>(P, li, it, C.lane, vbuf);
}

__device__ __forceinline__ void phase_post(const Params& P, const Ctx& C, int li) {
    unsigned char* ws = P.ws;
    const float* YF = (const float*)(ws + Z_YF); const float* YBk = (const float*)(ws + Z_YBK);
    const hf* GRW = (const hf*)(ws + Z_GRW); const hf* BON = (const hf*)(ws + Z_BONUS); hf* YA = (hf*)(ws + Z_YA);
    const int c = C.tid;
    const float lg = P.in[I_RW_LNG][li * 512 + c], lb = P.in[I_RW_LNB][li * 512 + c];
    for (int m0 = C.bid * 4; m0 < M; m0 += C.G * 4) {
        float y[4], bo[4], gr[4];
#pragma unroll
        for (int u = 0; u < 4; ++u) { const size_t o = (size_t)(m0 + u) * 512 + c; y[u] = YF[o] + YBk[o]; bo[u] = (float)BON[o]; gr[u] = (float)GRW[o]; }
#pragma unroll
        for (int u = 0; u < 4; ++u) {
            const float mean = wave_sum(y[u], C.lane) * (1.0f / 64.0f), dl = y[u] - mean, var = wave_sum(dl * dl, C.lane) * (1.0f / 64.0f);
            const float yn = dl * rsqrtf(var + 64e-5f) * lg + lb;
            YA[(size_t)(m0 + u) * 512 + c] = (hf)((yn + bo[u]) * gr[u]);
        }
    }
    const hf* DO = (const hf*)(ws + Z_DILO); const float* LSE = (const float*)(ws + Z_LSE); hf* YB = (hf*)(ws + Z_YB);
    for (int i = C.bid * NTHR + C.tid; i < M * 64; i += C.G * NTHR) {
        const int m = i >> 6, c4 = i & 63, hq = c4 >> 4;
        const float l0 = LSE[((size_t)0 * M + m) * 4 + hq], l1 = LSE[((size_t)1 * M + m) * 4 + hq], l2 = LSE[((size_t)2 * M + m) * 4 + hq];
        const float mx = fmaxf(l0, fmaxf(l1, l2)); float w0 = __expf(l0 - mx), w1 = __expf(l1 - mx), w2 = __expf(l2 - mx); const float inv = 1.0f / (w0 + w1 + w2);
        w0 *= inv; w1 *= inv; w2 *= inv;
        const hf4 a = *(const hf4*)(DO + ((size_t)0 * M + m) * 256 + 4 * c4), bq = *(const hf4*)(DO + ((size_t)1 * M + m) * 256 + 4 * c4), cq = *(const hf4*)(DO + ((size_t)2 * M + m) * 256 + 4 * c4);
        u32x2 w; w.x = pkh(w0 * (float)a.x + w1 * (float)bq.x + w2 * (float)cq.x, w0 * (float)a.y + w1 * (float)bq.y + w2 * (float)cq.y);
        w.y = pkh(w0 * (float)a.z + w1 * (float)bq.z + w2 * (float)cq.z, w0 * (float)a.w + w1 * (float)bq.w + w2 * (float)cq.w);
        *(u32x2*)(YB + (size_t)m * 256 + 4 * c4) = w;
    }
}


#ifdef DBG
#ifndef DBG_LAST
#define DBG_LAST 6
#endif
constexpr size_t WS_DBG = WS_END;
__device__ __forceinline__ unsigned dbg_hash(unsigned x) { x ^= x >> 16; x *= 0x7feb352dU; x ^= x >> 15; x *= 0x846ca68bU; x ^= x >> 16; return x; }
__device__ __forceinline__ bool dbg_bad(float ref, float got) { return !(fabsf(ref - got) <= 0.03f * fabsf(ref) + 0.03f); }
__device__ __forceinline__ float dbg_cs(const float* RW, const float* mu, int m, int col) {
    const int t = m & (T - 1); const float x0 = RW[(size_t)m * RWP + col], xm = t > 0 ? RW[(size_t)(m - 1) * RWP + col] : 0.f, xp = t < T - 1 ? RW[(size_t)(m + 1) * RWP + col] : 0.f;
    return x0 + mu[col] * (0.5f * (xm + xp) - x0);
}
__device__ __forceinline__ float dbg_dot_hw(const hf* a, const float* w, int K, int ldw) { float acc = 0.f;
#pragma unroll 1
    for (int k = 0; k < K; ++k) acc += (float)a[k] * (float)(hf)w[(size_t)k * ldw]; return acc; }
__device__ __noinline__ void dbg_phase_checks(const Params& P, int ph, int tid, LAS float* st) {
    unsigned char* ws = P.ws; unsigned* dbg = (unsigned*)(ws + WS_DBG);
    const unsigned h1 = dbg_hash(tid * 4 + 1 + ph * 7919), h2 = dbg_hash(tid * 4 + 2 + ph * 7919), h3 = dbg_hash(tid * 4 + 3 + ph * 7919);
    const hf* H = (const hf*)(ws + WS_H); const hf* QKV = (const hf*)(ws + Z_QKV);
    if (ph == 3) {
        const float* RW = (const float*)(ws + Z_RWBUF); const float* mu = P.in[I_RW_MU];
        const int m = h1 % M, c = h2 % 512, hb = (c >> 6) << 6, b = m >> 12, t = m & (T - 1), h = c >> 6, e = c & 63;
        const float r = dbg_cs(RW, mu, m, c), k = dbg_cs(RW, mu, m, 512 + c), v = dbg_cs(RW, mu, m, 1024 + c);
        float ld[2], kdo[2] = {0.f, 0.f}, lro[2] = {0.f, 0.f}, bon = 0.f, gate = 0.f, nrm = 0.f;
#pragma unroll 1
        for (int l = 0; l < 96; ++l) gate += sigmoidf_(dbg_cs(RW, mu, m, 1664 + l)) * P.in[I_RW_G2][l * 512 + c];
#pragma unroll 1
        for (int n = 0; n < 64; ++n) { const float q = dbg_cs(RW, mu, m, 512 + hb + n) * P.in[I_RW_KK][hb + n]; nrm += q * q; }
        const float kk = k * P.in[I_RW_KK][c] / fmaxf(sqrtf(nrm), 1e-12f);
#pragma unroll 1
        for (int d = 0; d < 2; ++d) {
            float z = P.in[I_RW_W0][d * 512 + c];
#pragma unroll 1
            for (int l = 0; l < 32; ++l) z += tanhf(dbg_cs(RW, mu, m, 1536 + 32 * d + l)) * P.in[I_RW_W2][(d * 32 + l) * 512 + c];
            ld[d] = -0.60653066f * 1.44269504f * sigmoidf_(z);
            float dot = 0.f;
#pragma unroll 1
            for (int n = 0; n < 64; ++n) {
                float za = P.in[I_RW_A0][d * 512 + hb + n];
#pragma unroll 1
                for (int l = 0; l < 32; ++l) za += dbg_cs(RW, mu, m, 1600 + 32 * d + l) * P.in[I_RW_A2][(d * 32 + l) * 512 + hb + n];
                const float lr = sigmoidf_(za), kd = dbg_cs(RW, mu, m, 512 + hb + n) * (1.0f + (lr - 1.0f) * P.in[I_RW_KA][hb + n]);
                dot += dbg_cs(RW, mu, m, hb + n) * kd * P.in[I_RW_RK][hb + n];
                if (hb + n == c) { kdo[d] = kd; lro[d] = lr; }
            }
            bon += dot * v;
        }
        const hf* s1 = (const hf*)(ws + Z_S1) + ((size_t)(b * 8 + h) * T + t) * 192 + e;
        bool bad = dbg_bad(r, (float)s1[0]) || dbg_bad(-kk, (float)s1[64]) || dbg_bad(v, (float)s1[128]);
        for (int d = 0; d < 2; ++d) { const hf* s2 = (const hf*)(ws + Z_S2) + ((size_t)((d * 4 + b) * 8 + h) * T + t) * 192 + e;
            bad = bad || dbg_bad(ld[d], (float)s2[0]) || dbg_bad(kdo[d], (float)s2[64]) || dbg_bad(kk * lro[d], (float)s2[128]); }
        if (bad) atomicAdd(dbg + 0, 1u);
        if (dbg_bad(gate, (float)((const hf*)(ws + Z_GRW))[(size_t)m * 512 + c]) || dbg_bad(bon, (float)((const hf*)(ws + Z_BONUS))[(size_t)m * 512 + c])) atomicAdd(dbg + 1, 1u);
    } else if (ph == 4) {
        {
            const int chain = tid & 63, d = chain >> 5, b = (chain >> 3) & 3, h = chain & 7, i = h1 & 63;
            const hf* s1 = (const hf*)(ws + Z_S1) + (size_t)(b * 8 + h) * T * 192; const hf* s2 = (const hf*)(ws + Z_S2) + (size_t)((d * 4 + b) * 8 + h) * T * 192;
            const float* Y = (const float*)(ws + (d ? Z_YBK : Z_YF));
            for (int j = 0; j < 64; ++j) st[j * 512 + tid] = 0.f;
            bool bad = false;
#pragma unroll 1
            for (int s = 0; s < 256; ++s) {
                const int t = d ? T - 1 - s : s; const hf* p1 = s1 + (size_t)t * 192; const hf* p2 = s2 + (size_t)t * 192;
                float sa = 0.f;
#pragma unroll 1
                for (int j = 0; j < 64; ++j) sa += st[j * 512 + tid] * (float)p1[64 + j];
                const float v = (float)p1[128 + i]; float y = 0.f;
#pragma unroll 1
                for (int j = 0; j < 64; ++j) { const float nv = st[j * 512 + tid] * exp2f((float)p2[j]) + sa * (float)p2[128 + j] + v * (float)p2[64 + j]; st[j * 512 + tid] = nv; y += nv * (float)p1[j]; }
                if (!bad && dbg_bad(y, Y[((size_t)b * T + t) * 512 + h * 64 + i])) { bad = true; atomicMin(dbg + 12, (unsigned)s); }
            }
            if (bad) { atomicAdd(dbg + 2, 1u); atomicAdd(dbg + 10 + d, 1u); }
        }
        {
            const int tok = h1 % M, head = h2 % 12, e = h3 & 63, b = tok >> 12, t = tok & (T - 1), g = head >> 2, ldil = 2 * g, j = t >> ldil, res = t & ((1 << ldil) - 1), nsub = T >> ldil;
            const hf* q = QKV + (size_t)tok * QKVW + head * 64;
            float mx = -3e38f;
#pragma unroll 1
            for (int pass = 0; pass < 2; ++pass) {
                float sum = 0.f, acc = 0.f;
#pragma unroll 1
                for (int jk = max(0, j - 64); jk <= min(nsub - 1, j + 64); ++jk) {
                    const hf* kr = QKV + (size_t)(b * T + (jk << ldil) + res) * QKVW;
                    float sc = 0.f; for (int x = 0; x < 64; ++x) sc += (float)q[x] * (float)kr[768 + head * 64 + x];
                    if (pass == 0) mx = fmaxf(mx, sc); else { const float p = __expf(sc - mx); sum += p; acc += p * (float)kr[1536 + head * 64 + e]; }
                }
                if (pass == 1) {
                    const float o = acc / sum, lse = mx + __logf(sum);
                    if (dbg_bad(o, (float)((const hf*)(ws + Z_DILO))[((size_t)g * M + tok) * 256 + (head & 3) * 64 + e]) || dbg_bad(lse, ((const float*)(ws + Z_LSE))[((size_t)g * M + tok) * 4 + (head & 3)])) atomicAdd(dbg + 3, 1u);
                }
            }
        }
        {
            const int tok = h2 % M, head = h3 % 12, e = h1 & 63, b = tok >> 12, t = tok & (T - 1), r = t >> 6, qc = t & 63, r0 = min(max(r - 4, 0), 56), wc0 = min(max(qc - 8, 0), 48);
            const hf* q = QKV + (size_t)tok * QKVW + 2304 + head * 64; const float* bias = P.in[I_NA_BIAS] + (size_t)head * 15 * 31;
            float mx = -3e38f;
#pragma unroll 1
            for (int pass = 0; pass < 2; ++pass) {
                float sum = 0.f, acc = 0.f;
#pragma unroll 1
                for (int kidx = 0; kidx < 128; ++kidx) {
                    const int y = kidx >> 4, kc = wc0 + (kidx & 15);
                    const hf* kr = QKV + (size_t)(b * T + (r0 + y) * 64 + kc) * QKVW;
                    float sc = 0.f; for (int x = 0; x < 64; ++x) sc += (float)q[x] * (float)kr[3072 + head * 64 + x];
                    sc = sc * 0.125f + bias[(r0 + y - r + 7) * 31 + min(max(kc - qc, -15), 15) + 15];
                    if (pass == 0) mx = fmaxf(mx, sc); else { const float p = __expf(sc - mx); sum += p; acc += p * (float)kr[3840 + head * 64 + e]; }
                }
                if (pass == 1 && dbg_bad(acc / sum, (float)((const hf*)(ws + Z_YC))[(size_t)tok * 768 + head * 64 + e])) atomicAdd(dbg + 4, 1u);
            }
        }
    } else if (ph == 5) {
        {
            const int m = h1 % M, c = h2 % 512, hb = (c >> 6) << 6;
            const float* YF = (const float*)(ws + Z_YF); const float* YK = (const float*)(ws + Z_YBK);
            float mean = 0.f, var = 0.f;
            for (int n = 0; n < 64; ++n) mean += YF[(size_t)m * 512 + hb + n] + YK[(size_t)m * 512 + hb + n];
            mean *= (1.0f / 64.0f);
            for (int n = 0; n < 64; ++n) { const float dl = YF[(size_t)m * 512 + hb + n] + YK[(size_t)m * 512 + hb + n] - mean; var += dl * dl; }
            var *= (1.0f / 64.0f);
            const float yn = (YF[(size_t)m * 512 + c] + YK[(size_t)m * 512 + c] - mean) * rsqrtf(var + 64e-5f) * P.in[I_RW_LNG][c] + P.in[I_RW_LNB][c];
            const float ya = (yn + (float)((const hf*)(ws + Z_BONUS))[(size_t)m * 512 + c]) * (float)((const hf*)(ws + Z_GRW))[(size_t)m * 512 + c];
            const int c2 = h3 % 256, hq = c2 >> 6; const float* LSE = (const float*)(ws + Z_LSE); const hf* DO = (const hf*)(ws + Z_DILO);
            const float l0 = LSE[((size_t)0 * M + m) * 4 + hq], l1 = LSE[((size_t)1 * M + m) * 4 + hq], l2 = LSE[((size_t)2 * M + m) * 4 + hq], mx = fmaxf(l0, fmaxf(l1, l2));
            const float w0 = __expf(l0 - mx), w1 = __expf(l1 - mx), w2 = __expf(l2 - mx);
            const float yb = (w0 * (float)DO[((size_t)0 * M + m) * 256 + c2] + w1 * (float)DO[((size_t)1 * M + m) * 256 + c2] + w2 * (float)DO[((size_t)2 * M + m) * 256 + c2]) / (w0 + w1 + w2);
            if (dbg_bad(ya, (float)((const hf*)(ws + Z_YA))[(size_t)m * 512 + c]) || dbg_bad(yb, (float)((const hf*)(ws + Z_YB))[(size_t)m * 256 + c2])) atomicAdd(dbg + 5, 1u);
        }
        {
            const int row = h2 % M, col = h1 % NGATE;
            const float gt = sigmoidf_(dbg_dot_hw(H + (size_t)row * D, P.in[I_W_IN] + RW_COLS + QKVW + col, D, IN_COLS));
            if (dbg_bad(gt, (float)((const hf*)(ws + Z_GATES))[(size_t)row * NGATE + col])) atomicAdd(dbg + 6, 1u);
        }
    } else if (ph == 6) {
        const int row = h1 % M, col = h2 % D; const hf* GT = (const hf*)(ws + Z_GATES) + (size_t)row * NGATE;
        const float mg = (float)GT[col] * dbg_dot_hw((const hf*)(ws + Z_YA) + (size_t)row * 512, P.in[I_W_BRA] + col, 512, D)
                       + (float)GT[D + col] * dbg_dot_hw((const hf*)(ws + Z_YB) + (size_t)row * 256, P.in[I_W_BRB] + col, 256, D)
                       + (float)GT[2 * D + col] * dbg_dot_hw((const hf*)(ws + Z_YC) + (size_t)row * 768, P.in[I_W_BRC] + col, 768, D);
        if (dbg_bad(mg, (float)H[(size_t)row * D + col])) atomicAdd(dbg + 7, 1u);
    } else if (ph == 7) {
        const int row = h1 % M, col = h2 % D;
        const float o = P.in[I_X][(size_t)row * D + col] + dbg_dot_hw(H + (size_t)row * D, P.in[I_W_OUT] + col, D, D);
        if (dbg_bad(o, P.out[(size_t)row * D + col])) atomicAdd(dbg + 8, 1u);
    }
}
#endif
#ifndef ONLY
#define ONLY -1
#endif
#ifdef DBG
#define EN(n) ((n) <= DBG_LAST)
#else
#define EN(n) (ONLY < 0 || ONLY == (n))
#endif
constexpr int PH_PER_LAYER = 13, N_PHASES = 2 * PH_PER_LAYER + 1;
template <class Epi> __device__ __forceinline__ void run_gemm(const Ctx& C, const void* A, const void* Bt, int N, int K, const Epi& E, int Gs = -1, int cs = -1) {
    pg8::Gemm g{(const pg8::bf16_t*)A, (const pg8::bf16_t*)Bt, M, N, K}; pg8::StaticOrder S; S.init(M, N, Gs > 0 ? Gs : C.G, Gs > 0 ? cs : C.bid);
    pg8::gemm_phase<Epi, pg8::StaticOrder>(C.lds, g, S, E, C.tid);
}
#define XB_TMO      128
#define XB_XCNT(j)  (256  + 64 * (j))
#define XB_XSUB(j)  (1280 + 64 * (j))
#define XB_XGEN(j)  (2304 + 64 * (j))
#define XB_TOP      3328
#define XB_TOPGEN   3392
#define XCD_BAR_WORDS 3456
#define XB_SPIN_CAP (1u << 18)

__device__ __forceinline__ unsigned xb_ld(unsigned* p)              { return __hip_atomic_load(p, __ATOMIC_RELAXED, __HIP_MEMORY_SCOPE_AGENT); }
__device__ __forceinline__ unsigned xb_add(unsigned* p, unsigned v) { return __hip_atomic_fetch_add(p, v, __ATOMIC_RELAXED, __HIP_MEMORY_SCOPE_AGENT); }
__device__ __forceinline__ unsigned xb_xcc_id() { return (unsigned)__builtin_amdgcn_s_getreg((3 << 11) | 20) & 0xFu; }
#define XB_SPIN(cond, bar) do { unsigned _sp = 0; while (cond) { __builtin_amdgcn_s_sleep(1); \
    if ((++_sp & 255u) == 0u) { if (xb_ld(&(bar)[XB_TMO])) break; if (_sp > XB_SPIN_CAP) { atomicAdd(&(bar)[XB_TMO], 1u); break; } } } } while (0)

struct XcdBarrier {
    unsigned* bar; unsigned x;
    volatile LAS unsigned* st;
};

__device__ __forceinline__ XcdBarrier xcd_barrier_post(unsigned* bar, volatile LAS unsigned* st, bool leader) {
    XcdBarrier b; b.bar = bar; b.x = xb_xcc_id(); b.st = st;
    if (leader) (void)xb_add(&bar[XB_XCNT(b.x)], 1u);
    return b;
}
__device__ __forceinline__ void xcd_barrier_complete(unsigned* bar, unsigned x, unsigned& nloc, unsigned& nx) {
    const unsigned G = gridDim.x * gridDim.y * gridDim.z;
    unsigned sum, cnt, mine, sp = 0u;
    for (;;) {
        sum = 0u; cnt = 0u; mine = 0u;
#pragma unroll
        for (unsigned j = 0; j < 16; ++j) { const unsigned c = xb_ld(&bar[XB_XCNT(j)]); sum += c; cnt += (c > 0u) ? 1u : 0u; mine = (j == x) ? c : mine; }
        if (sum == G) break;
        __builtin_amdgcn_s_sleep(1);
        if ((++sp & 255u) == 0u) { if (xb_ld(&bar[XB_TMO])) break; if (sp > XB_SPIN_CAP) { atomicAdd(&bar[XB_TMO], 1u); break; } }
    }
    nloc = mine > 0u ? mine : 1u; nx = cnt > 0u ? cnt : 1u;
}

__device__ __forceinline__ void xcd_barrier(const XcdBarrier& b, bool leader) {
    asm volatile("s_waitcnt vmcnt(0)" ::: "memory");
    __syncthreads();
    if (leader) {
        unsigned* bar = b.bar;
        __builtin_amdgcn_s_waitcnt(0);
        unsigned nloc = b.st[0], nx = b.st[1];
        if (nloc == 0u) { xcd_barrier_complete(bar, b.x, nloc, nx); b.st[0] = nloc; b.st[1] = nx; }
        const unsigned old = xb_add(&bar[XB_XSUB(b.x)], 1u);
        const unsigned gen = old / nloc;
        if (old + 1u == (gen + 1u) * nloc) {
            __builtin_amdgcn_fence(__ATOMIC_RELEASE, "agent");
            asm volatile("s_waitcnt vmcnt(0)" ::: "memory");
            const unsigned og = xb_add(&bar[XB_TOP], 1u);
            const unsigned tg = og / nx;
            if (og + 1u == (tg + 1u) * nx) xb_add(&bar[XB_TOPGEN], 1u);
            else XB_SPIN(xb_ld(&bar[XB_TOPGEN]) == tg, bar);
            __builtin_amdgcn_fence(__ATOMIC_ACQUIRE, "agent");
            xb_add(&bar[XB_XGEN(b.x)], 1u);
            asm volatile("s_waitcnt vmcnt(0)" ::: "memory");
        } else {
            XB_SPIN(xb_ld(&bar[XB_XGEN(b.x)]) == gen, bar);
            __builtin_amdgcn_fence(__ATOMIC_ACQUIRE, "agent");
            asm volatile("s_waitcnt vmcnt(0)" ::: "memory");
        }
    }
    __syncthreads();
}


typedef __attribute__((address_space(4))) const Params* CPP;
__device__ __forceinline__ int lane_id() { int m1 = -1; asm volatile("" : "+s"(m1)); return __builtin_amdgcn_mbcnt_hi(m1, __builtin_amdgcn_mbcnt_lo(m1, 0)); }
constexpr size_t WS_BAR = WS_END + 1 * MiB;
constexpr size_t Z_B16 = WS_Z + 272 * MiB;
constexpr size_t Z_GA = WS_Z + 64 * MiB, WS_GA2 = WS_END + 2 * MiB, WS_NEED = WS_GA2 + 16 * MiB;
constexpr int LDS_BARST = 131072;
__device__ __forceinline__ void grid_seam(const XcdBarrier& xb, int wave_s) {
    const bool leader = wave_s == 0 && lane_id() == 0;
    xcd_barrier(xb, leader);
}
#define PHASE_BEGIN { CPP pp_ = (CPP)__builtin_amdgcn_kernarg_segment_ptr(); asm volatile("" : "+s"(pp_)); const Params& P = *(const Params*)pp_; \
    Ctx C; { int w_ = wave_s; asm volatile("" : "+s"(w_)); int t_ = w_ * 64 + lane_id(); asm volatile("" : "+v"(t_)); int b_ = blockIdx.x, g_ = gridDim.x; asm volatile("" : "+s"(b_), "+s"(g_)); \
      C.lds = (LAS unsigned char*)lds_raw; C.tid = t_; C.lane = t_ & 63; C.wave = __builtin_amdgcn_readfirstlane(t_ >> 6); C.bid = b_; C.G = g_; C.gw = b_ * NWAVES + C.wave; C.NGW = g_ * NWAVES; } \
    unsigned char* ws = P.ws; hf* H = (hf*)(ws + WS_H); (void)H;
#define PHASE_END }
#ifdef DBG
#define DBG_CHECK(ph) if (LI == 0 && (ph) >= 3 && (ph) <= DBG_LAST + 1) { PHASE_BEGIN \
        if (C.bid == 0) dbg_phase_checks(P, (ph), C.tid, (LAS float*)C.lds); \
        grid_seam(xb, wave_s); \
        if ((ph) == DBG_LAST + 1) { \
            const unsigned* dbg = (const unsigned*)(ws + WS_DBG); unsigned bits = 0; \
            for (int k2 = 0; k2 < 9; ++k2) bits |= (__hip_atomic_load(dbg + k2, __ATOMIC_RELAXED, __HIP_MEMORY_SCOPE_AGENT) > 0u ? 1u : 0u) << k2; \
            const int d1 = 1 + (bits & 7), d2 = (bits >> 3) & 7, d3 = (bits >> 6) & 7; \
            const float v0 = 1000.f * d1 + 100.f * d2, v1 = sqrtf(256.f * d3); \
            for (size_t i = (size_t)C.bid * NTHR + C.tid; i < (size_t)M * D; i += (size_t)C.G * NTHR) P.out[i] = i == 0 ? v0 : (i <= 65536 ? v1 : 0.f); \
            return true; } PHASE_END }
#else
#define DBG_CHECK(ph)
#endif
#define SEAM(ph) for (int rs_ = 0; rs_ < REP_SEAM; ++rs_) grid_seam(xb, wave_s); DBG_CHECK(ph)
#ifndef REP_GEMM
#define REP_GEMM 1
#endif
#ifndef REP_SCAN
#define REP_SCAN 1
#endif
#ifndef REP_ATTN
#define REP_ATTN 1
#endif
#ifndef REP_PRE
#define REP_PRE 1
#endif
#ifndef REP_SEAM
#define REP_SEAM 1
#endif
#ifndef REP_OTH
#define REP_OTH 1
#endif
#ifndef REP_MISC
#define REP_MISC 1
#endif
template <int LI> __device__ __forceinline__ bool run_layer(const XcdBarrier& xb, unsigned char* lds_raw, int wave_s) {
    constexpr int li = LI;
    PHASE_BEGIN
#ifdef DBG
        if (li == 0 && C.bid == 0 && C.tid < 16) ((unsigned*)(ws + WS_DBG))[C.tid] = C.tid == 12 ? 999u : 0u;
#endif
        for (int rep_ = 0; rep_ < REP_MISC; ++rep_) { phase_convert(P, C, li); __syncthreads(); phase_norm(li == 0 ? P.in[I_X] : P.out, P.in[I_NORM_MIX] + li * D, H, C); }
    PHASE_END SEAM(1)
    PHASE_BEGIN for (int rep_ = 0; rep_ < REP_GEMM; ++rep_) { { pg8::EpiIn1 E{(float*)(ws + Z_RWBUF), (hf*)(ws + Z_QKV)}; run_gemm(C, H, ws + WS_WIN, NIN1, D, E); } }
        {
            const int nfull = (64 * (NIN1 / 256)) % C.G;
            if (nfull > 0 && nfull < C.G) { if (C.bid >= nfull) phase_convert_part(P, C, li, 1, (C.bid - nfull) * NWAVES + C.wave, (C.G - nfull) * NWAVES); }
            else phase_convert_part(P, C, li, 1, C.gw, C.NGW);
        }
    PHASE_END SEAM(2)
    PHASE_BEGIN for (int rep_ = 0; rep_ < REP_PRE; ++rep_) { phase_rwkv_pre(P, C, li); } PHASE_END
    PHASE_BEGIN phase_rope(P, C); PHASE_END SEAM(3)
    PHASE_BEGIN {
        const int nscan = C.G >= 2 ? min(128, C.G / 2) : 1;
        if (C.G < 2) { phase_scan(P, C, 1); phase_attn(P, C, li, C.gw, C.NGW); phase_gate_lora(P, C, li, 0, 1); __syncthreads();
                       { pg8::EpiGates E{(hf*)(ws + Z_GA), D, GA_SPLIT, (hf*)(ws + WS_GA2), 1 << 30, nullptr, 0}; run_gemm(C, H, (hf*)(ws + WS_WIN) + (size_t)NIN1 * D, GA_EARLY, D, E); } }
        else if (C.bid < nscan) { for (int rep_ = 0; rep_ < REP_SCAN; ++rep_) { phase_scan(P, C, nscan); } }
        else { for (int rep_ = 0; rep_ < REP_ATTN; ++rep_) { phase_attn(P, C, li, (C.bid - nscan) * NWAVES + C.wave, (C.G - nscan) * NWAVES); }
               phase_gate_lora(P, C, li, C.bid - nscan, C.G - nscan);
               __syncthreads();
               { pg8::EpiGates E{(hf*)(ws + Z_GA), D, GA_SPLIT, (hf*)(ws + WS_GA2), 1 << 30, nullptr, 0}; run_gemm(C, H, (hf*)(ws + WS_WIN) + (size_t)NIN1 * D, GA_EARLY, D, E, C.G - nscan, C.bid - nscan); } }
    } PHASE_END SEAM(4)
    PHASE_BEGIN for (int rep_ = 0; rep_ < REP_MISC; ++rep_) { phase_post(P, C, li); } PHASE_END
    PHASE_BEGIN for (int rep_ = 0; rep_ < REP_GEMM; ++rep_) { { pg8::EpiGates E{(hf*)(ws + Z_GA) + GA_EARLY, D, GA_SPLIT, (hf*)(ws + WS_GA2) + GA_EARLY, D - GA_EARLY, (hf*)(ws + Z_GATES), 2 * D}; run_gemm(C, H, (hf*)(ws + WS_WIN) + (size_t)(NIN1 + GA_EARLY) * D, 3 * D - GA_EARLY, D, E); } } PHASE_END SEAM(5)
    PHASE_BEGIN for (int rep_ = 0; rep_ < REP_OTH; ++rep_) { pg8::EpiF16 Ea{(hf*)(ws + Z_MACC), D}; run_gemm(C, ws + Z_YA, ws + WS_WA, D, 512, Ea); } PHASE_END
    PHASE_BEGIN for (int rep_ = 0; rep_ < REP_OTH; ++rep_) { pg8::EpiF16 Eb{(hf*)(ws + Z_B16), D}; run_gemm(C, ws + Z_YB, ws + WS_WB, D, 256, Eb); } PHASE_END
    PHASE_BEGIN for (int rep_ = 0; rep_ < REP_OTH; ++rep_) { pg8::EpiMerge Ec{(const hf*)(ws + Z_GA), (const hf*)(ws + WS_GA2), (const hf*)(ws + Z_GATES), (const hf*)(ws + Z_MACC), (const hf*)(ws + Z_B16), H}; run_gemm(C, ws + Z_YC, ws + WS_WC, D, 768, Ec); } PHASE_END SEAM(6)
    PHASE_BEGIN for (int rep_ = 0; rep_ < REP_OTH; ++rep_) { pg8::EpiResid E{li == 0 ? P.in[I_X] : P.out, rep_ + 1 < REP_OTH ? (float*)(ws + Z_MACC) : P.out}; run_gemm(C, H, ws + WS_WO, D, D, E); } PHASE_END SEAM(7)
    PHASE_BEGIN for (int rep_ = 0; rep_ < REP_MISC; ++rep_) { phase_norm(P.out, P.in[I_NORM_FFN] + li * D, H, C); } PHASE_END SEAM(8)
    PHASE_BEGIN for (int rep_ = 0; rep_ < REP_GEMM; ++rep_) { { pg8::EpiF16 E{(hf*)(ws + Z_G), FF}; run_gemm(C, H, ws + WS_WG, FF, D, E); } }
        if (li == 0 && C.G == 256 && C.bid >= 128) phase_convert_part(P, C, 1, 0, (C.bid - 128) * NWAVES + C.wave, 128 * NWAVES);
        if (li == 1 && C.G == 256 && C.bid >= 128) { pg8::EpiF16 Ep{(hf*)(ws + Z_PP), D}; run_gemm(C, (hf*)(ws + WS_P16) + (size_t)li * M * PLE, ws + WS_WP, 1024, PLE, Ep, 128, C.bid - 128); }
    PHASE_END SEAM(9)
    PHASE_BEGIN for (int rep_ = 0; rep_ < REP_GEMM; ++rep_) { { pg8::EpiUp E{(const hf*)(ws + Z_G), P.in[I_CONV_W] + (size_t)li * 3 * FF, P.in[I_CONV_B] + (size_t)li * FF, (hf*)(ws + Z_ACT)}; run_gemm(C, H, ws + WS_WU, FF, D, E); } }
        if (li == 0 && C.G == 256 && C.bid >= 128) phase_convert_part(P, C, 1, 2, (C.bid - 128) * NWAVES + C.wave, 128 * NWAVES);
        if (li == 1 && C.G == 256 && C.bid >= 128) { pg8::EpiF16 Ep{(hf*)(ws + Z_PP) + 1024, D}; run_gemm(C, (hf*)(ws + WS_P16) + (size_t)li * M * PLE, (hf*)(ws + WS_WP) + (size_t)1024 * PLE, 1024, PLE, Ep, 128, C.bid - 128); }
    PHASE_END SEAM(10)
    PHASE_BEGIN for (int rep_ = 0; rep_ < REP_OTH; ++rep_) { pg8::EpiResid E{P.out, rep_ + 1 < REP_OTH ? (float*)(ws + Z_G) : P.out}; run_gemm(C, ws + Z_ACT, ws + WS_WD, D, FF, E); } PHASE_END SEAM(11)
    PHASE_BEGIN for (int rep_ = 0; rep_ < REP_MISC; ++rep_) { phase_norm(P.out, P.in[I_NORM_PLE] + li * D, H, C); } PHASE_END
    PHASE_BEGIN if (!(li == 1 && C.G == 256)) { for (int rep_ = 0; rep_ < REP_OTH; ++rep_) { pg8::EpiF16 E{(hf*)(ws + Z_PP), D}; run_gemm(C, (hf*)(ws + WS_P16) + (size_t)li * M * PLE, ws + WS_WP, D, PLE, E); } } PHASE_END SEAM(12)
    PHASE_BEGIN for (int rep_ = 0; rep_ < REP_OTH; ++rep_) { pg8::EpiPle E{(const hf*)(ws + Z_PP), P.out, rep_ + 1 < REP_OTH ? (float*)(ws + Z_G) : P.out}; run_gemm(C, H, ws + WS_WPG, D, D, E); } PHASE_END SEAM(13)
    return false;
}
__global__ void __launch_bounds__(NTHR, 2) mega_fwd(Params P_arg) {
    extern __shared__ __attribute__((aligned(16))) unsigned char lds_raw[];
    cg::grid_group grid = cg::this_grid();
    const int wave_s = __builtin_amdgcn_readfirstlane((int)threadIdx.x >> 6);
    if (threadIdx.x < 2) ((LAS unsigned*)((LAS unsigned char*)lds_raw + LDS_BARST))[threadIdx.x] = 0u;
    __syncthreads();
    XcdBarrier xb = xcd_barrier_post((unsigned*)(P_arg.ws + WS_BAR), (volatile LAS unsigned*)((LAS unsigned char*)lds_raw + LDS_BARST), threadIdx.x == 0);
    grid.sync();
    if (run_layer<0>(xb, lds_raw, wave_s)) return;
    if (run_layer<1>(xb, lds_raw, wave_s)) return;
    PHASE_BEGIN phase_final_norm(P.out, P.in[I_NORM_FINAL], C); PHASE_END
}

extern "C" void kernel_launch(void* const* d_in, const int* in_sizes, int n_in, void* d_out, int out_size, void* d_ws, size_t ws_size, hipStream_t stream) {
    static int grid = 0;
    if (grid == 0) {
        if (n_in != 30 || ws_size < WS_NEED) { fprintf(stderr, "kernel_launch: need 30 inputs and %zu bytes of workspace; got %d, %zu\n", (size_t)WS_END, n_in, ws_size); grid = -1; return; }
        int dev = 0, cus = 0, per_cu = 0;
        hipGetDevice(&dev); hipDeviceGetAttribute(&cus, hipDeviceAttributeMultiprocessorCount, dev);
        if (hipFuncSetAttribute((const void*)mega_fwd, hipFuncAttributeMaxDynamicSharedMemorySize, LDS_BYTES) != hipSuccess) fprintf(stderr, "kernel_launch: hipFuncSetAttribute failed\n");
        if (hipOccupancyMaxActiveBlocksPerMultiprocessor(&per_cu, (const void*)mega_fwd, NTHR, LDS_BYTES) != hipSuccess || per_cu < 1) { fprintf(stderr, "kernel_launch: occupancy query says %d\n", per_cu); per_cu = 1; }
        (void)hipGetLastError();
        grid = cus * 1;
        fprintf(stderr, "kernel_launch: grid %d (cus %d, per_cu %d), ws %zu\n", grid, cus, per_cu, ws_size);
    }
    if (grid < 0) return;
    if (hipMemsetAsync((char*)d_ws + WS_BAR, 0, 16384, stream) != hipSuccess) fprintf(stderr, "kernel_launch: memset of barrier words failed\n");
    Params p{};
    for (int i = 0; i < 30; ++i) p.in[i] = (const float*)d_in[i];
    p.out = (float*)d_out; p.ws = (unsigned char*)d_ws; p.ph_lo = 0; p.ph_hi = 0;
    void* args[] = {&p};
    hipError_t e = hipLaunchCooperativeKernel((const void*)mega_fwd, dim3(grid), dim3(NTHR), args, LDS_BYTES, stream);
    if (e != hipSuccess) fprintf(stderr, "kernel_launch: cooperative launch failed: %s\n", hipGetErrorString(e));
}
```

```cpp
#include <hip/hip_runtime.h>
#include <hip/hip_cooperative_groups.h>
#include <cstdio>
#include <cstdint>
namespace cg = cooperative_groups;

#define GAS __attribute__((address_space(1)))
#define LAS __attribute__((address_space(3)))
typedef _Float16 hf;
typedef _Float16 hf8 __attribute__((ext_vector_type(8)));
typedef _Float16 hf4 __attribute__((ext_vector_type(4)));
typedef _Float16 hf2 __attribute__((ext_vector_type(2)));
typedef float f32x4 __attribute__((ext_vector_type(4)));
typedef float f32x2 __attribute__((ext_vector_type(2)));
typedef unsigned u32x4 __attribute__((ext_vector_type(4)));
typedef unsigned u32x2 __attribute__((ext_vector_type(2)));

constexpr int M = 16384, D = 2048, T = 4096, FF = 5632, PLE = 256;
constexpr int IN_COLS = 12512, RW_COLS = 1760, RWP = 1792, QKVW = 4608, NIN1 = 6400, NGATE = 6144, NINP = 12544;
constexpr int NWAVES = 8, NTHR = 512;
constexpr int GA_EARLY = 1024;
constexpr int GA_SPLIT = 12288;
constexpr int LDS_BYTES = 131072 + 2048;

constexpr size_t MiB = (size_t)1 << 20;
constexpr size_t WS_WIN = 0, WS_WA = 49 * MiB, WS_WB = 51 * MiB, WS_WC = 52 * MiB, WS_WO = 55 * MiB, WS_WG = 63 * MiB, WS_WU = 85 * MiB, WS_WD = 107 * MiB,
                 WS_WPG = 129 * MiB, WS_WP = 137 * MiB, WS_ROPE = 138 * MiB, WS_P16 = 139 * MiB, WS_H = 155 * MiB, WS_Z = 219 * MiB;
constexpr size_t Z_RWBUF = WS_Z, Z_YF = WS_Z, Z_YBK = WS_Z + 32 * MiB, Z_GRW = WS_Z + 112 * MiB, Z_BONUS = WS_Z + 128 * MiB, Z_QKV = WS_Z + 144 * MiB,
                 Z_S1 = WS_Z + 288 * MiB, Z_S2 = WS_Z + 336 * MiB, Z_YA = WS_Z + 432 * MiB, Z_YB = WS_Z + 448 * MiB, Z_YC = WS_Z + 456 * MiB,
                 Z_DILO = WS_Z + 480 * MiB, Z_LSE = WS_Z + 504 * MiB, WS_END = WS_Z + 505 * MiB;
constexpr size_t Z_SG = WS_Z + 432 * MiB;
constexpr size_t Z_GATES = WS_Z + 144 * MiB, Z_MACC = WS_Z, Z_G = WS_Z, Z_ACT = WS_Z + 176 * MiB, Z_PP = WS_Z + 352 * MiB;

__device__ __forceinline__ unsigned pkh(float a, float b) { hf2 h = {(hf)a, (hf)b}; return __builtin_bit_cast(unsigned, h); }
__device__ __forceinline__ float sigmoidf_(float x) { return __builtin_amdgcn_rcpf(1.0f + __expf(-x)); }
__device__ __forceinline__ float dpp_allsum16(float x) {
    x += __builtin_bit_cast(float, __builtin_amdgcn_update_dpp(0, __builtin_bit_cast(int, x), 0xB1, 0xF, 0xF, false));
    x += __builtin_bit_cast(float, __builtin_amdgcn_update_dpp(0, __builtin_bit_cast(int, x), 0x4E, 0xF, 0xF, false));
    x += __builtin_bit_cast(float, __builtin_amdgcn_update_dpp(0, __builtin_bit_cast(int, x), 0x141, 0xF, 0xF, false));
    x += __builtin_bit_cast(float, __builtin_amdgcn_update_dpp(0, __builtin_bit_cast(int, x), 0x140, 0xF, 0xF, false));
    return x;
}
__device__ __forceinline__ float xor_shfl(float v, int lane, int mask) { return __builtin_bit_cast(float, __builtin_amdgcn_ds_bpermute((lane ^ mask) << 2, __builtin_bit_cast(int, v))); }
__device__ __forceinline__ float wave_sum(float v, int lane) { v = dpp_allsum16(v); v += xor_shfl(v, lane, 16); v += xor_shfl(v, lane, 32); return v; }
__device__ __forceinline__ u32x4 pack8(const f32x4 a, const f32x4 b) { u32x4 o; o.x = pkh(a.x, a.y); o.y = pkh(a.z, a.w); o.z = pkh(b.x, b.y); o.w = pkh(b.z, b.w); return o; }
__device__ __forceinline__ void unpack8(const u32x4 v, f32x4& a, f32x4& b) {
    const unsigned x0 = v.x, x1 = v.y, x2 = v.z, x3 = v.w;
    hf2 h0 = __builtin_bit_cast(hf2, x0), h1 = __builtin_bit_cast(hf2, x1), h2 = __builtin_bit_cast(hf2, x2), h3 = __builtin_bit_cast(hf2, x3);
    a = (f32x4){(float)h0.x, (float)h0.y, (float)h1.x, (float)h1.y}; b = (f32x4){(float)h2.x, (float)h2.y, (float)h3.x, (float)h3.y};
}

namespace pg8 {
#define PG8_LAS __attribute__((address_space(3)))
typedef unsigned short bf16_t;
typedef short bf16x8 __attribute__((ext_vector_type(8)));
constexpr int BM = 256, BK = 64, HALF = 128, HTB = HALF * BK * 2  , STAGE_BYTES = 8 * HTB, NXCD = 8, WGM = 8;

__host__ __device__ __forceinline__ int lds_byte(int r, int c) { const int st = (r >> 4) * 2 + (c >> 5), rr = r & 15, cc = c & 31, ob = rr * 64 + cc * 2; return st * 1024 + (ob ^ (((ob >> 9) & 1) << 5)); }
__host__ __device__ __forceinline__ void stage_rc(int b, int& R, int& C) { const int st = b / 1024, sb = b % 1024, swz = sb ^ (((sb >> 9) & 1) << 5); R = (st >> 1) * 16 + swz / 64; C = (st & 1) * 32 + (swz % 64) / 2; }
__host__ __device__ __forceinline__ int perm32(int rho) { const int n = rho >> 4, i = rho & 15; return 8 * (i >> 2) + 4 * n + (i & 3); }

struct Unit { int pm, pn; };
struct Gemm { const bf16_t* A; const bf16_t* Bt; int M, N, K; };

struct StaticOrder {
    int nM, nN, nwg, G, c;
    __host__ __device__ void init(int M, int N, int G_, int c_) { nM = M / BM; nN = N / BM; nwg = nM * nN; G = G_; c = c_; }
    __host__ __device__ bool next(int i, Unit& u) const {
        const long L = (long)i * G + c; if (L >= nwg) return false;
        int wgid = (int)L; { const int q = nwg / NXCD, r = nwg % NXCD, xcd = wgid % NXCD, off = wgid / NXCD; wgid = (xcd < r ? xcd * (q + 1) : r * (q + 1) + (xcd - r) * q) + off; }
        const int nig = WGM * nN, gid = wgid / nig, fm = gid * WGM, gsz = (nM - fm) < WGM ? (nM - fm) : WGM;
        u.pm = fm + ((wgid % nig) % gsz); u.pn = (wgid % nig) / gsz; return true;
    }
    __device__ __forceinline__ void a_ready(const Unit&) const {}
    __device__ __forceinline__ void done(const Unit&) const {}
};

#define EPI_LOOP_BEGIN \
    _Pragma("unroll") for (int bj = 0; bj < 2; ++bj) { const int col = u.pn * BM + bj * HALF + wc * 32 + 8 * fq; (void)col;
#define EPI_ROWS_BEGIN \
    _Pragma("unroll") for (int ai = 0; ai < 2; ++ai) { _Pragma("unroll") for (int m = 0; m < 4; ++m) { const int row = u.pm * BM + ai * HALF + wr * 64 + m * 16 + fr; const f32x4 v0 = acc[ai][bj][m][0], v1 = acc[ai][bj][m][1];
#define EPI_END } } }
typedef f32x4 Acc[2][2][4][2];

struct EpiIn1 {
    static constexpr bool PERM = true, AFTER_DRAIN = false;
    float* rw; hf* qkv;
    __device__ __forceinline__ void operator()(const Acc& acc, const Unit& u, int wr, int wc, int fr, int fq) const {
        if (u.pn < 7) {
            EPI_LOOP_BEGIN EPI_ROWS_BEGIN
                float* p = rw + (size_t)row * RWP + col; *(f32x4*)p = v0; *(f32x4*)(p + 4) = v1;
            EPI_END
        } else {
            EPI_LOOP_BEGIN EPI_ROWS_BEGIN
                *(u32x4*)(qkv + (size_t)row * QKVW + (col - 7 * BM)) = pack8(v0, v1);
            EPI_END
        }
    }
};
struct EpiGates {
    static constexpr bool PERM = true, AFTER_DRAIN = false;
    hf* O; int ldc; int split_row; hf* O2; int csplit; hf* P2; int ldp;
    __device__ __forceinline__ void operator()(const Acc& acc, const Unit& u, int wr, int wc, int fr, int fq) const {
        const bool first = u.pn * BM < csplit;
        EPI_LOOP_BEGIN EPI_ROWS_BEGIN
            f32x4 a, b;
#pragma unroll
            for (int i = 0; i < 4; ++i) { a[i] = sigmoidf_(v0[i]); b[i] = sigmoidf_(v1[i]); }
            hf* base = first ? (row < split_row ? O + (size_t)row * ldc : O2 + (size_t)(row - split_row) * ldc) + col : P2 + (size_t)row * ldp + (col - csplit);
            *(u32x4*)base = pack8(a, b);
        EPI_END
    }
};
struct EpiF16 {
    static constexpr bool PERM = true, AFTER_DRAIN = false;
    hf* O; int ldc;
    __device__ __forceinline__ void operator()(const Acc& acc, const Unit& u, int wr, int wc, int fr, int fq) const {
        EPI_LOOP_BEGIN EPI_ROWS_BEGIN
            *(u32x4*)(O + (size_t)row * ldc + col) = pack8(v0, v1);
        EPI_END
    }
};
template <int MODE> struct EpiBranch {
    static constexpr bool PERM = true, AFTER_DRAIN = false;
    const hf* gates; int goff; float* macc; hf* merged;
    __device__ __forceinline__ void operator()(const Acc& acc, const Unit& u, int wr, int wc, int fr, int fq) const {
        EPI_LOOP_BEGIN EPI_ROWS_BEGIN
            f32x4 g0, g1; unpack8(*(const u32x4*)(gates + (size_t)row * NGATE + goff + col), g0, g1);
            float* p = macc + (size_t)row * D + col;
            f32x4 r0 = g0 * v0, r1 = g1 * v1;
            if (MODE >= 1) { r0 += *(const f32x4*)p; r1 += *(const f32x4*)(p + 4); }
            if (MODE <= 1) { *(f32x4*)p = r0; *(f32x4*)(p + 4) = r1; }
            else *(u32x4*)(merged + (size_t)row * D + col) = pack8(r0, r1);
        EPI_END
    }
};
struct EpiMerge {
    static constexpr bool PERM = true, AFTER_DRAIN = false;
    const hf* ga1; const hf* ga2; const hf* gbc; const hf* A16; const hf* B16; hf* merged;
    __device__ __forceinline__ void operator()(const Acc& acc, const Unit& u, int wr, int wc, int fr, int fq) const {
#pragma unroll
        for (int bj = 0; bj < 2; ++bj) {
            const int col = u.pn * BM + bj * HALF + wc * 32 + 8 * fq;
#pragma unroll
            for (int ai = 0; ai < 2; ++ai)
#pragma unroll
                for (int mh = 0; mh < 2; ++mh) {
                    u32x4 ra[2], rb[2], rc[2], rx[2], ry[2];
#pragma unroll
                    for (int mm = 0; mm < 2; ++mm) { const int row = u.pm * BM + ai * HALF + wr * 64 + (2 * mh + mm) * 16 + fr; const hf* gp = gbc + (size_t)row * (2 * D) + col; const hf* ap = row < GA_SPLIT ? ga1 + (size_t)row * D : ga2 + (size_t)(row - GA_SPLIT) * D;
                        ra[mm] = *(const u32x4*)(ap + col); rb[mm] = *(const u32x4*)gp; rc[mm] = *(const u32x4*)(gp + D);
                        rx[mm] = *(const u32x4*)(A16 + (size_t)row * D + col); ry[mm] = *(const u32x4*)(B16 + (size_t)row * D + col); }
                    asm volatile("" ::: "memory");
#pragma unroll
                    for (int mm = 0; mm < 2; ++mm) { const int m = 2 * mh + mm, row = u.pm * BM + ai * HALF + wr * 64 + m * 16 + fr;
                        f32x4 ga0, ga1, gb0, gb1, gc0, gc1, a0, a1, b0, b1;
                        unpack8(ra[mm], ga0, ga1); unpack8(rb[mm], gb0, gb1); unpack8(rc[mm], gc0, gc1); unpack8(rx[mm], a0, a1); unpack8(ry[mm], b0, b1);
                        *(u32x4*)(merged + (size_t)row * D + col) = pack8(ga0 * a0 + gb0 * b0 + gc0 * acc[ai][bj][m][0], ga1 * a1 + gb1 * b1 + gc1 * acc[ai][bj][m][1]); }
                    asm volatile("" ::: "memory");
                }
        }
    }
};
struct EpiResid {
    static constexpr bool PERM = true, AFTER_DRAIN = false;
    const float* xin; float* xout;
    __device__ __forceinline__ void operator()(const Acc& acc, const Unit& u, int wr, int wc, int fr, int fq) const {
#pragma unroll
        for (int bj = 0; bj < 2; ++bj) {
            const int col = u.pn * BM + bj * HALF + wc * 32 + 8 * fq;
#pragma unroll
            for (int ai = 0; ai < 2; ++ai) {
                f32x4 xa[4], xb[4];
#pragma unroll
                for (int m = 0; m < 4; ++m) { const float* p = xin + (size_t)(u.pm * BM + ai * HALF + wr * 64 + m * 16 + fr) * D + col; xa[m] = *(const f32x4*)p; xb[m] = *(const f32x4*)(p + 4); }
                asm volatile("" ::: "memory");
#pragma unroll
                for (int m = 0; m < 4; ++m) { float* q = xout + (size_t)(u.pm * BM + ai * HALF + wr * 64 + m * 16 + fr) * D + col;
                    *(f32x4*)q = xa[m] + acc[ai][bj][m][0]; *(f32x4*)(q + 4) = xb[m] + acc[ai][bj][m][1]; }
                asm volatile("" ::: "memory");
            }
        }
    }
};
__device__ __forceinline__ float gelu_tanh(float x) {
    const float u2 = 1.5957691216f * (x + 0.044715f * x * x * x);
    return x * __builtin_amdgcn_rcpf(1.0f + __expf(-u2));
}
struct EpiUp {
    static constexpr bool PERM = true, AFTER_DRAIN = false;
    const hf* G; const float* cw; const float* cb; hf* O;
    __device__ __forceinline__ void operator()(const Acc& acc, const Unit& u, int wr, int wc, int fr, int fq) const {
#pragma unroll
        for (int bj = 0; bj < 2; ++bj) {
            const int col = u.pn * BM + bj * HALF + wc * 32 + 8 * fq;
            const f32x4 w0a = *(const f32x4*)(cw + col), w0b = *(const f32x4*)(cw + col + 4), w1a = *(const f32x4*)(cw + FF + col), w1b = *(const f32x4*)(cw + FF + col + 4),
                        w2a = *(const f32x4*)(cw + 2 * FF + col), w2b = *(const f32x4*)(cw + 2 * FF + col + 4), ba = *(const f32x4*)(cb + col), bb = *(const f32x4*)(cb + col + 4);
#pragma unroll
            for (int ai = 0; ai < 2; ++ai) {
#pragma unroll
                for (int mh = 0; mh < 2; ++mh) {
                    u32x4 rc[2], rm[2], rp[2];
#pragma unroll
                    for (int mm = 0; mm < 2; ++mm) {
                        const int m = 2 * mh + mm, row = u.pm * BM + ai * HALF + wr * 64 + m * 16 + fr, t = row & (T - 1);
                        const hf* gp = G + (size_t)row * FF + col;
                        rc[mm] = *(const u32x4*)gp; rm[mm] = *(const u32x4*)(t > 0 ? gp - FF : gp); rp[mm] = *(const u32x4*)(t < T - 1 ? gp + FF : gp);
                    }
                    asm volatile("" ::: "memory");
#pragma unroll
                    for (int mm = 0; mm < 2; ++mm) {
                        const int m = 2 * mh + mm, row = u.pm * BM + ai * HALF + wr * 64 + m * 16 + fr, t = row & (T - 1);
                        const f32x4 v0 = acc[ai][bj][m][0], v1 = acc[ai][bj][m][1];
                        const float fm = t > 0 ? 1.0f : 0.0f, fp_ = t < T - 1 ? 1.0f : 0.0f;
                        f32x4 c0, c1, m0, m1, p0, p1;
                        unpack8(rc[mm], c0, c1); unpack8(rm[mm], m0, m1); unpack8(rp[mm], p0, p1);
                        f32x4 ga = m0 * (w0a * fm) + c0 * w1a + p0 * (w2a * fp_) + ba, gb = m1 * (w0b * fm) + c1 * w1b + p1 * (w2b * fp_) + bb;
#pragma unroll
                        for (int i = 0; i < 4; ++i) { ga[i] = gelu_tanh(ga[i]) * v0[i]; gb[i] = gelu_tanh(gb[i]) * v1[i]; }
                        *(u32x4*)(O + (size_t)row * FF + col) = pack8(ga, gb);
                    }
                    asm volatile("" ::: "memory");
                }
            }
        }
    }
};
struct EpiPle {
    static constexpr bool PERM = true, AFTER_DRAIN = false;
    const hf* pp; float* x; float* xo;
    __device__ __forceinline__ void operator()(const Acc& acc, const Unit& u, int wr, int wc, int fr, int fq) const {
#pragma unroll
        for (int bj = 0; bj < 2; ++bj) {
            const int col = u.pn * BM + bj * HALF + wc * 32 + 8 * fq;
#pragma unroll
            for (int ai = 0; ai < 2; ++ai) {
                f32x4 xa[4], xb[4]; u32x4 pr[4];
#pragma unroll
                for (int m = 0; m < 4; ++m) { const size_t o = (size_t)(u.pm * BM + ai * HALF + wr * 64 + m * 16 + fr) * D + col;
                    xa[m] = *(const f32x4*)(x + o); xb[m] = *(const f32x4*)(x + o + 4); pr[m] = *(const u32x4*)(pp + o); }
                asm volatile("" ::: "memory");
#pragma unroll
                for (int m = 0; m < 4; ++m) { const size_t o = (size_t)(u.pm * BM + ai * HALF + wr * 64 + m * 16 + fr) * D + col;
                    f32x4 p0, p1; unpack8(pr[m], p0, p1); f32x4 a = xa[m], b2 = xb[m]; const f32x4 v0 = acc[ai][bj][m][0], v1 = acc[ai][bj][m][1];
#pragma unroll
                    for (int i = 0; i < 4; ++i) { a[i] += sigmoidf_(v0[i]) * p0[i]; b2[i] += sigmoidf_(v1[i]) * p1[i]; }
                    *(f32x4*)(xo + o) = a; *(f32x4*)(xo + o + 4) = b2; }
                asm volatile("" ::: "memory");
            }
        }
    }
};

template <class Epi, class Sched>
__device__ __forceinline__ void gemm_phase(PG8_LAS unsigned char* lds, const Gemm g, const Sched& S, const Epi& E, int tid_in) {
    int tid_l = tid_in; asm volatile("" : "+v"(tid_l));
    const int tid = tid_l, wid = __builtin_amdgcn_readfirstlane(tid >> 6), lane = tid & 63, wr = wid >> 2, wc = wid & 3, fr = lane & 15, fq = lane >> 4;
    const int K = g.K, nt = K / BK;
    unsigned voffA[2], voffB[2];
#pragma unroll
    for (int i = 0; i < 2; ++i) { int R, C; stage_rc(tid * 16 + i * 8192, R, C); const int Rb = Epi::PERM ? ((R & ~31) + perm32(R & 31)) : R;
        voffA[i] = (unsigned)(R * K + C) * 2u; voffB[i] = (unsigned)(Rb * K + C) * 2u; }
    const size_t kstep = (size_t)(BK * 2);
    const size_t hstep = (size_t)HALF * K * 2;
    const size_t tstep = 2 * hstep;
    const unsigned ldsw = (unsigned)wid * 1024u;
    const int aoff = lds_byte(wr * 64 + fr, fq * 8), boff = lds_byte(wc * 32 + fr, fq * 8);
#define PG8_SA(b, h) (((b) * 2 + (h)) * HTB)
#define PG8_SB(b, h) ((4 + (b) * 2 + (h)) * HTB)
#define PG8_STAGE(bufoff, gbase, voff) do { _Pragma("unroll") for (int _i = 0; _i < 2; ++_i) \
        __builtin_amdgcn_global_load_lds((const unsigned*)((const char*)(gbase) + (voff)[_i]), (PG8_LAS unsigned*)(lds + (bufoff) + ldsw + _i * 8192), 16, 0, 0); } while (0)
#define PG8_LDA(dst, b, h) do { _Pragma("unroll") for (int m = 0; m < 4; ++m) _Pragma("unroll") for (int k = 0; k < 2; ++k) dst[m][k] = *(const PG8_LAS bf16x8*)(lds + PG8_SA(b, h) + aoff + m * 2048 + k * 1024); } while (0)
#define PG8_LDB(dst, b, h) do { _Pragma("unroll") for (int n = 0; n < 2; ++n) _Pragma("unroll") for (int k = 0; k < 2; ++k) dst[n][k] = *(const PG8_LAS bf16x8*)(lds + PG8_SB(b, h) + boff + n * 2048 + k * 1024); } while (0)
#define PG8_MMA(ai, bj, At, Bt) do { __builtin_amdgcn_s_setprio(1); _Pragma("unroll") for (int m = 0; m < 4; ++m) _Pragma("unroll") for (int n = 0; n < 2; ++n) _Pragma("unroll") for (int k = 0; k < 2; ++k) \
        acc[ai][bj][m][n] = __builtin_amdgcn_mfma_f32_16x16x32_f16(__builtin_bit_cast(hf8, Bt[n][k]), __builtin_bit_cast(hf8, At[m][k]), acc[ai][bj][m][n], 0, 0, 0); __builtin_amdgcn_s_setprio(0); } while (0)
#define PG8_WAIT_V(n) asm volatile("s_waitcnt vmcnt(" #n ")" ::: "memory")
#define PG8_WAIT_L(n) asm volatile("s_waitcnt lgkmcnt(" #n ")" ::: "memory")
#define PG8_BAR __builtin_amdgcn_s_barrier()
#define PG8_SCHED __builtin_amdgcn_sched_barrier(0)
    Unit cur, nxt; int ui = 0;
    if (!S.next(0, cur)) return;
    f32x4 acc[2][2][4][2];
#pragma unroll
    for (int a = 0; a < 2; ++a)
#pragma unroll
        for (int b = 0; b < 2; ++b)
#pragma unroll
            for (int m = 0; m < 4; ++m)
#pragma unroll
                for (int n = 0; n < 2; ++n) acc[a][b][m][n] = (f32x4){0.f, 0.f, 0.f, 0.f};
    bf16x8 At[4][2], B0[2][2], B1[2][2];
    const char* cA = (const char*)g.A + (size_t)cur.pm * tstep; const char* cB = (const char*)g.Bt + (size_t)cur.pn * tstep;
    S.a_ready(cur);
    PG8_STAGE(PG8_SB(0, 0), cB, voffB); PG8_STAGE(PG8_SA(0, 0), cA, voffA); PG8_STAGE(PG8_SB(0, 1), cB + hstep, voffB); PG8_STAGE(PG8_SA(0, 1), cA + hstep, voffA);
    if (wr == 1) PG8_BAR;
    PG8_WAIT_V(4); PG8_BAR;
    PG8_STAGE(PG8_SB(1, 0), cB + kstep, voffB); PG8_STAGE(PG8_SA(1, 0), cA + kstep, voffA); PG8_STAGE(PG8_SB(1, 1), cB + hstep + kstep, voffB);
    PG8_WAIT_V(6); PG8_BAR;
    for (;;) {
        const bool has_next = S.next(ui + 1, nxt);
        const char* nA = has_next ? (const char*)g.A + (size_t)nxt.pm * tstep : cA; const char* nB = has_next ? (const char*)g.Bt + (size_t)nxt.pn * tstep : cB;
        for (int t = 0; t < nt; t += 2) {
            const bool last = (t == nt - 2);
            const char* a1 = cA + (size_t)(t + 1) * kstep;
            const char* a2 = last ? nA : cA + (size_t)(t + 2) * kstep; const char* b2 = last ? nB : cB + (size_t)(t + 2) * kstep;
            const char* a3 = a2 + kstep; const char* b3 = b2 + kstep;
            if (last && has_next) S.a_ready(nxt);
            PG8_LDB(B0, 0, 0); PG8_SCHED; PG8_LDA(At, 0, 0); PG8_STAGE(PG8_SA(1, 1), a1 + hstep, voffA);
            PG8_WAIT_L(8); PG8_BAR; PG8_WAIT_L(0); PG8_MMA(0, 0, At, B0); PG8_BAR; PG8_SCHED;
            PG8_LDB(B1, 0, 1); PG8_STAGE(PG8_SB(0, 0), b2, voffB);
            PG8_BAR; PG8_WAIT_L(0); PG8_MMA(0, 1, At, B1); PG8_BAR;
            PG8_LDA(At, 0, 1); PG8_STAGE(PG8_SA(0, 0), a2, voffA);
            PG8_BAR; PG8_WAIT_L(0); PG8_MMA(1, 0, At, B0); PG8_BAR; PG8_SCHED;
            PG8_STAGE(PG8_SB(0, 1), b2 + hstep, voffB);
            PG8_WAIT_V(6); PG8_BAR; PG8_MMA(1, 1, At, B1); PG8_BAR;
            PG8_LDB(B0, 1, 0); PG8_SCHED; PG8_LDA(At, 1, 0); PG8_STAGE(PG8_SA(0, 1), a2 + hstep, voffA);
            PG8_WAIT_L(8); PG8_BAR; PG8_WAIT_L(0); PG8_MMA(0, 0, At, B0); PG8_BAR; PG8_SCHED;
            PG8_LDB(B1, 1, 1); PG8_STAGE(PG8_SB(1, 0), b3, voffB);
            PG8_BAR; PG8_WAIT_L(0); PG8_MMA(0, 1, At, B1); PG8_BAR;
            PG8_LDA(At, 1, 1); PG8_STAGE(PG8_SA(1, 0), a3, voffA);
            PG8_BAR; PG8_WAIT_L(0); PG8_MMA(1, 0, At, B0); PG8_BAR; PG8_SCHED;
            PG8_STAGE(PG8_SB(1, 1), b3 + hstep, voffB);
            PG8_WAIT_V(6); PG8_BAR; PG8_MMA(1, 1, At, B1); PG8_BAR;
        }
        if constexpr (!Epi::AFTER_DRAIN) { E(acc, cur, wr, wc, fr, fq); S.done(cur); }
        if (!has_next) break;
#pragma unroll
        for (int a = 0; a < 2; ++a)
#pragma unroll
            for (int b = 0; b < 2; ++b)
#pragma unroll
                for (int m = 0; m < 4; ++m)
#pragma unroll
                    for (int n = 0; n < 2; ++n) acc[a][b][m][n] = (f32x4){0.f, 0.f, 0.f, 0.f};
        cur = nxt; cA = nA; cB = nB; ++ui;
    }
    PG8_WAIT_V(0);
    if (wr == 0) PG8_BAR;
    PG8_BAR;
    if constexpr (Epi::AFTER_DRAIN) { E.fused(acc, cur, wr, wc, fr, fq, lds, wid, lane); S.done(cur); }
#undef PG8_SA
#undef PG8_SB
#undef PG8_STAGE
#undef PG8_LDA
#undef PG8_LDB
#undef PG8_MMA
#undef PG8_WAIT_V
#undef PG8_WAIT_L
#undef PG8_BAR
#undef PG8_SCHED
}
}
struct Params {
    const float* in[30];
    float* out; unsigned char* ws;
    int ph_lo, ph_hi;
};
enum { I_X = 0, I_P, I_NORM_MIX, I_W_IN, I_RW_MU, I_RW_W0, I_RW_W2, I_RW_A0, I_RW_A2, I_RW_G2, I_RW_KK, I_RW_KA, I_RW_RK, I_RW_LNG, I_RW_LNB, I_NA_BIAS,
       I_W_BRA, I_W_BRB, I_W_BRC, I_W_OUT, I_NORM_FFN, I_W_FG, I_W_FU, I_CONV_W, I_CONV_B, I_W_FD, I_NORM_PLE, I_W_PG, I_W_PLE, I_NORM_FINAL };

struct Ctx { LAS unsigned char* lds; int tid, lane, wave, G, gw, NGW, bid; };

#define LDS_WAIT() asm volatile("s_waitcnt lgkmcnt(0)" ::: "memory")

__device__ __forceinline__ void transpose_item(const float* W, int K, int N, hf* WT, int k0, int n0, int drow0, LAS float* scr, int lane) {
#pragma unroll 8
    for (int i = 0; i < 32; ++i) { const int kk = 2 * i + (lane >> 5); scr[kk * 33 + (lane & 31)] = W[(size_t)(k0 + kk) * N + n0 + (lane & 31)]; }
    LDS_WAIT();
    const int c = lane & 7;
#pragma unroll
    for (int j = 0; j < 4; ++j) { const int n = (lane >> 3) + 8 * j; const LAS float* s = scr + (8 * c) * 33 + n;
        u32x4 o; o.x = pkh(s[0 * 33], s[1 * 33]); o.y = pkh(s[2 * 33], s[3 * 33]); o.z = pkh(s[4 * 33], s[5 * 33]); o.w = pkh(s[6 * 33], s[7 * 33]);
        *(u32x4*)(WT + (size_t)(drow0 + n) * K + k0 + 8 * c) = o; }
    LDS_WAIT();
}
__device__ __forceinline__ bool conv_one(int& r, const float* W, int K, int N, hf* WT, LAS float* scr, int lane, bool remap, int nb0 = 0, int nb1 = 1 << 30) {
    const int nblk_all = N / 32, nblk = (nb1 < nblk_all ? nb1 : nblk_all) - nb0, items = (K / 64) * nblk;
    if (r >= items) { r -= items; return false; }
    const int kb = r / nblk, nb = nb0 + r % nblk, n0 = 32 * nb;
    int dr = n0;
    if (remap) dr = n0 < RW_COLS ? n0 : (n0 < RW_COLS + QKVW ? n0 - RW_COLS + RWP : n0 - (RW_COLS + QKVW) + NIN1);
    transpose_item(W, K, N, WT, 64 * kb, n0, dr, scr, lane);
    return true;
}
__device__ __forceinline__ void phase_convert_part(const Params& P, const Ctx& C, int li, int part, int gw, int ngw, int i0 = 0, int i1 = 1 << 30) {
    unsigned char* ws = P.ws;
    LAS float* scr = (LAS float*)(C.lds + C.wave * 16384);
    if (part == 0) {
        constexpr int NITEMS = 32 * 199 + 512 + 256 + 768 + 2048;
        for (int it = i0 + gw; it < (i1 < NITEMS ? i1 : NITEMS); it += ngw) {
            int r = it;
            if (conv_one(r, P.in[I_W_IN] + (size_t)li * D * IN_COLS, D, IN_COLS, (hf*)(ws + WS_WIN), scr, C.lane, true, 0, 199)) continue;
            if (conv_one(r, P.in[I_W_BRA] + (size_t)li * 512 * D, 512, D, (hf*)(ws + WS_WA), scr, C.lane, false)) continue;
            if (conv_one(r, P.in[I_W_BRB] + (size_t)li * 256 * D, 256, D, (hf*)(ws + WS_WB), scr, C.lane, false)) continue;
            if (conv_one(r, P.in[I_W_BRC] + (size_t)li * 768 * D, 768, D, (hf*)(ws + WS_WC), scr, C.lane, false)) continue;
            conv_one(r, P.in[I_W_OUT] + (size_t)li * D * D, D, D, (hf*)(ws + WS_WO), scr, C.lane, false);
        }
    } else if (part == 2) {
        constexpr int NITEMS = 32 * 192;
        for (int it = i0 + gw; it < (i1 < NITEMS ? i1 : NITEMS); it += ngw) { int r = it; conv_one(r, P.in[I_W_IN] + (size_t)li * D * IN_COLS, D, IN_COLS, (hf*)(ws + WS_WIN), scr, C.lane, true, 199, 391); }
    } else {
        constexpr int NITEMS = 3 * 5632 + 2048 + 256;
        for (int it = gw; it < NITEMS; it += ngw) {
            int r = it;
            if (conv_one(r, P.in[I_W_FG] + (size_t)li * D * FF, D, FF, (hf*)(ws + WS_WG), scr, C.lane, false)) continue;
            if (conv_one(r, P.in[I_W_FU] + (size_t)li * D * FF, D, FF, (hf*)(ws + WS_WU), scr, C.lane, false)) continue;
            if (conv_one(r, P.in[I_W_FD] + (size_t)li * FF * D, FF, D, (hf*)(ws + WS_WD), scr, C.lane, false)) continue;
            if (conv_one(r, P.in[I_W_PG] + (size_t)li * D * D, D, D, (hf*)(ws + WS_WPG), scr, C.lane, false)) continue;
            conv_one(r, P.in[I_W_PLE] + (size_t)li * PLE * D, PLE, D, (hf*)(ws + WS_WP), scr, C.lane, false);
        }
    }
}
__device__ __forceinline__ void phase_convert(const Params& P, const Ctx& C, int li) {
    unsigned char* ws = P.ws;
    if (!(li == 1 && C.G == 256)) { phase_convert_part(P, C, li, 0, C.gw, C.NGW); phase_convert_part(P, C, li, 2, C.gw, C.NGW); }
    if (li == 0) {
        float* rc = (float*)(ws + WS_ROPE); float* rs = rc + T * 32;
        for (int i = C.bid * NTHR + C.tid; i < T * 32; i += C.G * NTHR) {
            const int t = i >> 5, e = i & 31;
            const float inv = exp2f(-(float)e * 0.41524101186f);
            const float ang = (float)t * inv; float s, c; sincosf(ang, &s, &c); rc[i] = c; rs[i] = s;
        }
        const f32x4* p4 = (const f32x4*)P.in[I_P]; u32x2* o = (u32x2*)(ws + WS_P16);
        for (int i = C.bid * NTHR + C.tid; i < 2 * M * PLE / 4; i += C.G * NTHR) { const f32x4 v = p4[i]; u32x2 w; w.x = pkh(v.x, v.y); w.y = pkh(v.z, v.w); o[i] = w; }
    }
}
__device__ __forceinline__ void phase_norm(const float* xin, const float* gain, hf* hout, const Ctx& C) {
    for (int m = 2 * C.gw; m < M; m += 2 * C.NGW) {
        const f32x4* xr = (const f32x4*)(xin + (size_t)m * D) + C.lane;
        f32x4 v[2][8]; float s0 = 0.f, s1 = 0.f;
#pragma unroll
        for (int j = 0; j < 8; ++j) { v[0][j] = xr[64 * j]; v[1][j] = xr[64 * j + D / 4]; }
#pragma unroll
        for (int j = 0; j < 8; ++j) { s0 += (v[0][j].x * v[0][j].x + v[0][j].y * v[0][j].y) + (v[0][j].z * v[0][j].z + v[0][j].w * v[0][j].w);
                                      s1 += (v[1][j].x * v[1][j].x + v[1][j].y * v[1][j].y) + (v[1][j].z * v[1][j].z + v[1][j].w * v[1][j].w); }
        const float rs0 = rsqrtf(wave_sum(s0, C.lane) * (1.0f / D) + 1e-6f), rs1 = rsqrtf(wave_sum(s1, C.lane) * (1.0f / D) + 1e-6f);
        u32x2* o = (u32x2*)(hout + (size_t)m * D) + C.lane;
#pragma unroll
        for (int j = 0; j < 8; ++j) { const f32x4 g = ((const f32x4*)gain)[C.lane + 64 * j]; const f32x4 r0 = v[0][j] * rs0 * g, r1 = v[1][j] * rs1 * g;
            u32x2 w0, w1; w0.x = pkh(r0.x, r0.y); w0.y = pkh(r0.z, r0.w); w1.x = pkh(r1.x, r1.y); w1.y = pkh(r1.z, r1.w); o[64 * j] = w0; o[64 * j + D / 4] = w1; }
    }
}
__device__ __forceinline__ void phase_final_norm(float* x, const float* gain, const Ctx& C) {
    for (int m = 2 * C.gw; m < M; m += 2 * C.NGW) {
        f32x4* xr = (f32x4*)(x + (size_t)m * D) + C.lane;
        f32x4 v[2][8]; float s0 = 0.f, s1 = 0.f;
#pragma unroll
        for (int j = 0; j < 8; ++j) { v[0][j] = xr[64 * j]; v[1][j] = xr[64 * j + D / 4]; }
#pragma unroll
        for (int j = 0; j < 8; ++j) { s0 += (v[0][j].x * v[0][j].x + v[0][j].y * v[0][j].y) + (v[0][j].z * v[0][j].z + v[0][j].w * v[0][j].w);
                                      s1 += (v[1][j].x * v[1][j].x + v[1][j].y * v[1][j].y) + (v[1][j].z * v[1][j].z + v[1][j].w * v[1][j].w); }
        const float rs0 = rsqrtf(wave_sum(s0, C.lane) * (1.0f / D) + 1e-6f), rs1 = rsqrtf(wave_sum(s1, C.lane) * (1.0f / D) + 1e-6f);
#pragma unroll
        for (int j = 0; j < 8; ++j) { const f32x4 g = ((const f32x4*)gain)[C.lane + 64 * j]; xr[64 * j] = v[0][j] * rs0 * g; xr[64 * j + D / 4] = v[1][j] * rs1 * g; }
    }
}

constexpr int TT = 16;
__device__ __forceinline__ void phase_rwkv_pre(const Params& P, const Ctx& C, int li) {
    unsigned char* ws = P.ws;
    const float* RW = (const float*)(ws + Z_RWBUF);
    LAS float* cs = (LAS float*)C.lds;
    const float* mu = P.in[I_RW_MU] + li * RW_COLS;
    const float* w0 = P.in[I_RW_W0] + li * 1024; const float* w2 = P.in[I_RW_W2] + (size_t)li * 2 * 32 * 512;
    const float* a0 = P.in[I_RW_A0] + li * 1024; const float* a2 = P.in[I_RW_A2] + (size_t)li * 2 * 32 * 512;
    const int c = C.tid, h = C.wave, e = C.lane;
    const float kkc = P.in[I_RW_KK][li * 512 + c], kac = P.in[I_RW_KA][li * 512 + c], rkc = P.in[I_RW_RK][li * 512 + c];
    const float w00 = w0[c], w01 = w0[512 + c], a00 = a0[c], a01 = a0[512 + c];
    hf* S1 = (hf*)(ws + Z_S1); hf* S2 = (hf*)(ws + Z_S2); hf* SG = (hf*)(ws + Z_SG); hf* BON = (hf*)(ws + Z_BONUS);
    for (int tl = C.bid; tl < M / TT; tl += C.G) {
        const int m0 = tl * TT;
        for (int base = 0; base < TT * 440; base += 2 * NTHR) {
            f32x4 x0[2], xm[2], xp[2], mu4[2]; float fm[2], fp_[2]; int idxs[2];
#pragma unroll
            for (int u = 0; u < 2; ++u) {
                const int idx = min(base + u * NTHR + C.tid, TT * 440 - 1); idxs[u] = idx;
                const int tt = idx / 440, c4 = idx - tt * 440, m = m0 + tt, t = m & (T - 1);
                const float* p = RW + (size_t)m * RWP + 4 * c4;
                x0[u] = *(const f32x4*)p; xm[u] = *(const f32x4*)(t > 0 ? p - RWP : p); xp[u] = *(const f32x4*)(t < T - 1 ? p + RWP : p); mu4[u] = *(const f32x4*)(mu + 4 * c4);
                fm[u] = t > 0 ? 0.5f : 0.0f; fp_[u] = t < T - 1 ? 0.5f : 0.0f;
            }
            asm volatile("" ::: "memory");
#pragma unroll
            for (int u = 0; u < 2; ++u) if (base + u * NTHR + C.tid < TT * 440) {
                const int idx = idxs[u], tt = idx / 440, c4 = idx - tt * 440;
                f32x4 v = x0[u] + mu4[u] * ((xm[u] * fm[u] + xp[u] * fp_[u]) - x0[u]);
                if (c4 >= 384 && c4 < 400) { v.x = tanhf(v.x); v.y = tanhf(v.y); v.z = tanhf(v.z); v.w = tanhf(v.w); }
                else if (c4 >= 416) { v.x = sigmoidf_(v.x); v.y = sigmoidf_(v.y); v.z = sigmoidf_(v.z); v.w = sigmoidf_(v.w); }
                *(LAS f32x4*)(cs + tt * RW_COLS + 4 * c4) = v;
            }
        }
        __syncthreads();
        float zw0[TT], zw1[TT], za0[TT], za1[TT];
#pragma unroll
        for (int tt = 0; tt < TT; ++tt) { zw0[tt] = w00; zw1[tt] = w01; za0[tt] = a00; za1[tt] = a01; }
#pragma unroll 2
        for (int l0 = 0; l0 < 32; l0 += 4) {
            float ww0[4], ww1[4], aa0[4], aa1[4];
#pragma unroll
            for (int i = 0; i < 4; ++i) { ww0[i] = w2[(l0 + i) * 512 + c]; ww1[i] = w2[(32 + l0 + i) * 512 + c]; aa0[i] = a2[(l0 + i) * 512 + c]; aa1[i] = a2[(32 + l0 + i) * 512 + c]; }
#pragma unroll
            for (int tt = 0; tt < TT; ++tt) {
                const LAS float* q = cs + tt * RW_COLS;
                const f32x4 t0 = *(const LAS f32x4*)(q + 1536 + l0), t1 = *(const LAS f32x4*)(q + 1568 + l0), u0 = *(const LAS f32x4*)(q + 1600 + l0), u1 = *(const LAS f32x4*)(q + 1632 + l0);
#pragma unroll
                for (int i = 0; i < 4; ++i) { zw0[tt] += t0[i] * ww0[i]; zw1[tt] += t1[i] * ww1[i]; za0[tt] += u0[i] * aa0[i]; za1[tt] += u1[i] * aa1[i]; }
            }
        }
        for (int idx = C.tid; idx < TT * 96; idx += NTHR) { const int tt = idx / 96, l = idx - tt * 96; SG[(size_t)(m0 + tt) * 96 + l] = (hf)cs[tt * RW_COLS + 1664 + l]; }
#pragma unroll
        for (int tt = 0; tt < TT; ++tt) {
            const int m = m0 + tt, b = m >> 12, t = m & (T - 1);
            const LAS float* q = cs + tt * RW_COLS;
            const float r = q[c], k = q[512 + c], v = q[1024 + c];
            const float ld0 = -0.60653066f * 1.44269504f * sigmoidf_(zw0[tt]), ld1 = -0.60653066f * 1.44269504f * sigmoidf_(zw1[tt]);
            const float lr0 = sigmoidf_(za0[tt]), lr1 = sigmoidf_(za1[tt]);
            const float kkv = k * kkc;
            const float nrm = sqrtf(wave_sum(kkv * kkv, C.lane));
            const float kk = kkv / fmaxf(nrm, 1e-12f);
            const float kd0 = k * (1.0f + (lr0 - 1.0f) * kac), kd1 = k * (1.0f + (lr1 - 1.0f) * kac);
            const float bon = (wave_sum(r * kd0 * rkc, C.lane) + wave_sum(r * kd1 * rkc, C.lane)) * v;
            hf* s1 = S1 + ((size_t)(b * 8 + h) * T + t) * 192 + e;
            s1[0] = (hf)r; s1[64] = (hf)(-kk); s1[128] = (hf)v;
            hf* s20 = S2 + ((size_t)((0 * 4 + b) * 8 + h) * T + t) * 192 + e;
            hf* s21 = S2 + ((size_t)((1 * 4 + b) * 8 + h) * T + t) * 192 + e;
            s20[0] = (hf)ld0; s20[64] = (hf)kd0; s20[128] = (hf)(kk * lr0);
            s21[0] = (hf)ld1; s21[64] = (hf)kd1; s21[128] = (hf)(kk * lr1);
            BON[(size_t)m * 512 + c] = (hf)bon;
        }
        __syncthreads();
    }
}
__device__ __forceinline__ void phase_rope(const Params& P, const Ctx& C) {
    unsigned char* ws = P.ws;
    hf* QKV = (hf*)(ws + Z_QKV);
    const float* rc = (const float*)(ws + WS_ROPE); const float* rs = rc + T * 32;
    for (int i = C.bid * NTHR + C.tid; i < M * 2 * 12 * 4; i += C.G * NTHR) {
        const int c8 = i & 3, hh = (i >> 2) % 12, rest = (i >> 2) / 12, which = rest & 1, m = rest >> 1, t = m & (T - 1);
        hf* p = QKV + (size_t)m * QKVW + which * 768 + hh * 64 + 8 * c8;
        f32x4 a0_, a1_, b0_, b1_; unpack8(*(const u32x4*)p, a0_, a1_); unpack8(*(const u32x4*)(p + 32), b0_, b1_);
        const f32x4 c0 = *(const f32x4*)(rc + t * 32 + 8 * c8), c1 = *(const f32x4*)(rc + t * 32 + 8 * c8 + 4), s0 = *(const f32x4*)(rs + t * 32 + 8 * c8), s1 = *(const f32x4*)(rs + t * 32 + 8 * c8 + 4);
        const float sc = which == 0 ? 0.125f : 1.0f;
        const f32x4 o0 = (a0_ * c0 - b0_ * s0) * sc, o1 = (a1_ * c1 - b1_ * s1) * sc, o2 = (b0_ * c0 + a0_ * s0) * sc, o3 = (b1_ * c1 + a1_ * s1) * sc;
        *(u32x4*)p = pack8(o0, o1); *(u32x4*)(p + 32) = pack8(o2, o3);
    }
}

__device__ __forceinline__ void phase_gate_lora(const Params& P, const Ctx& C, int li, int wg, int nwg) {
    unsigned char* ws = P.ws;
    const hf* SG = (const hf*)(ws + Z_SG); hf* GRW = (hf*)(ws + Z_GRW);
    const float* g2 = P.in[I_RW_G2] + (size_t)li * 96 * 512;
    LAS float* sg = (LAS float*)C.lds;
    const int c = C.tid;
    __syncthreads();
    for (int tl = wg; tl < M / 32; tl += nwg) {
        const int m0 = tl * 32;
        if (C.tid < 32 * 96 / 8) {
            f32x4 a, b; unpack8(*(const u32x4*)(SG + (size_t)m0 * 96 + 8 * C.tid), a, b);
            *(LAS f32x4*)(sg + 8 * C.tid) = a; *(LAS f32x4*)(sg + 8 * C.tid + 4) = b;
        }
        __syncthreads();
        float acc[32];
#pragma unroll
        for (int tt = 0; tt < 32; ++tt) acc[tt] = 0.f;
#pragma unroll 2
        for (int l0 = 0; l0 < 96; l0 += 4) {
            float gg[4];
#pragma unroll
            for (int i = 0; i < 4; ++i) gg[i] = g2[(l0 + i) * 512 + c];
#pragma unroll
            for (int tt = 0; tt < 32; ++tt) { const f32x4 sv = *(const LAS f32x4*)(sg + tt * 96 + l0);
#pragma unroll
                for (int i = 0; i < 4; ++i) acc[tt] += sv[i] * gg[i]; }
        }
#pragma unroll
        for (int tt = 0; tt < 32; ++tt) GRW[(size_t)(m0 + tt) * 512 + c] = (hf)acc[tt];
        __syncthreads();
    }
}

constexpr int SB = 16, SSTEP = 352;
__device__ __forceinline__ void scan_load(const hf* s1, const hf* s2, int d, int n, int lt, u32x4 (&reg)[3]) {
#pragma unroll
    for (int j = 0; j < 3; ++j) {
        const int id = lt + 256 * j, s = id / 48, cc = id - s * 48, sa = SB * n + s, t = d ? (T - 1 - sa) : sa;
        const hf* src = cc < 24 ? (s1 + (size_t)t * 192 + cc * 8) : (s2 + (size_t)t * 192 + (cc - 24) * 8);
        reg[j] = *(const u32x4*)src;
    }
}
__device__ __forceinline__ void scan_store(LAS float* buf, int i0, int lt, const u32x4 (&reg)[3]) {
#pragma unroll
    for (int j = 0; j < 3; ++j) {
        const int id = lt + 256 * j, s = id / 48, cc = id - s * 48;
        f32x4 a, b; unpack8(reg[j], a, b);
        int dst;
        if (cc < 24) { const int arr = cc >> 3, e0 = (cc & 7) * 8;
            if (arr == 0) dst = 192 + e0; else if (arr == 1) dst = 256 + e0; else dst = (e0 >= i0 && e0 < i0 + 32) ? 320 + (e0 - i0) : -1;
        } else { const int c2 = cc - 24, arr = c2 >> 3, e0 = (c2 & 7) * 8;
            if (arr == 0) { dst = e0;
#pragma unroll
                for (int i = 0; i < 4; ++i) { a[i] = __builtin_amdgcn_exp2f(a[i]); b[i] = __builtin_amdgcn_exp2f(b[i]); } }
            else if (arr == 1) dst = 64 + e0; else dst = 128 + e0;
        }
        if (dst >= 0) { LAS float* q = buf + s * SSTEP + dst; *(LAS f32x4*)q = a; *(LAS f32x4*)(q + 4) = b; }
    }
}
__device__ __forceinline__ float dot4(const f32x4 S, const f32x4 a) { f32x2 p = (f32x2){S.x, S.y} * (f32x2){a.x, a.y}; p = (f32x2){S.z, S.w} * (f32x2){a.z, a.w} + p; return p.x + p.y; }
__device__ __forceinline__ float dpp_f(float x, int ctrl_sel) {
    const int xi = __builtin_bit_cast(int, x); int r;
    if (ctrl_sel == 0) r = __builtin_amdgcn_update_dpp(0, xi, 0x140, 0xF, 0xF, false);
    else if (ctrl_sel == 1) r = __builtin_amdgcn_update_dpp(0, xi, 0x141, 0xF, 0xF, false);
    else if (ctrl_sel == 2) r = __builtin_amdgcn_update_dpp(0, xi, 0x1B, 0xF, 0xF, false);
    else r = __builtin_amdgcn_update_dpp(0, xi, 0xB1, 0xF, 0xF, false);
    return __builtin_bit_cast(float, r);
}
__device__ __forceinline__ float rs16(const float (&p)[16], int lane) {
    const bool b3 = lane & 8, b2 = lane & 4, b1 = lane & 2, b0 = lane & 1;
    float q[8], r[4], u[2];
#pragma unroll
    for (int i = 0; i < 8; ++i) { const float keep = b3 ? p[i + 8] : p[i], send = b3 ? p[i] : p[i + 8]; q[i] = keep + dpp_f(send, 0); }
#pragma unroll
    for (int i = 0; i < 4; ++i) { const float keep = b2 ? q[i + 4] : q[i], send = b2 ? q[i] : q[i + 4]; r[i] = keep + dpp_f(send, 1); }
#pragma unroll
    for (int i = 0; i < 2; ++i) { const float keep = b1 ? r[i + 2] : r[i], send = b1 ? r[i] : r[i + 2]; u[i] = keep + dpp_f(send, 2); }
    const float keep = b0 ? u[1] : u[0], send = b0 ? u[0] : u[1];
    return keep + dpp_f(send, 3);
}
__device__ __forceinline__ void phase_scan(const Params& P, const Ctx& C, int nscan) {
    unsigned char* ws = P.ws;
    LAS float* buf = (LAS float*)C.lds;
    for (int item = C.bid; item < 128; item += nscan) {
        const int chain = item >> 1, hf_ = item & 1, d = chain >> 5, b = (chain >> 3) & 3, h = chain & 7, i0 = 32 * hf_;
        const hf* s1 = (const hf*)(ws + Z_S1) + (size_t)(b * 8 + h) * T * 192;
        const hf* s2 = (const hf*)(ws + Z_S2) + (size_t)((d * 4 + b) * 8 + h) * T * 192;
        float* yout = (float*)(ws + (d ? Z_YBK : Z_YF)) + (size_t)b * T * 512 + h * 64 + i0;
        const bool loader = C.wave >= 4;
        const int lt = C.tid - 256;
        u32x4 reg[3];
        if (loader) { scan_load(s1, s2, d, 0, lt, reg); scan_store(buf, i0, lt, reg); scan_load(s1, s2, d, 1, lt, reg); }
        __syncthreads();
        const int rowA = 8 * C.wave + (C.lane >> 4), rowB = rowA + 4, col0 = 4 * (C.lane & 15);
        f32x4 SA = {0.f, 0.f, 0.f, 0.f}, SBs = SA;
        for (int n = 0; n < T / SB; ++n) {
            if (loader) {
                if (n + 1 < T / SB) scan_store(buf + ((n + 1) & 1) * (SB * SSTEP), i0, lt, reg);
                if (n + 2 < T / SB) scan_load(s1, s2, d, n + 2, lt, reg);
            } else {
                const LAS float* bb = buf + (n & 1) * (SB * SSTEP);
                f32x4 w = *(const LAS f32x4*)(bb + col0), kd = *(const LAS f32x4*)(bb + 64 + col0), bv = *(const LAS f32x4*)(bb + 128 + col0),
                      r = *(const LAS f32x4*)(bb + 192 + col0), a = *(const LAS f32x4*)(bb + 256 + col0);
                float vA = bb[320 + rowA], vB = bb[320 + rowB];
                float pA[SB], pB[SB];
#pragma unroll
                for (int s = 0; s < SB; ++s) {
                    f32x4 nw = w, nkd = kd, nbv = bv, nr = r, na = a; float nvA = vA, nvB = vB;
                    if (s + 1 < SB) {
                        const LAS float* q = bb + (s + 1) * SSTEP;
                        nw = *(const LAS f32x4*)(q + col0); nkd = *(const LAS f32x4*)(q + 64 + col0); nbv = *(const LAS f32x4*)(q + 128 + col0);
                        nr = *(const LAS f32x4*)(q + 192 + col0); na = *(const LAS f32x4*)(q + 256 + col0); nvA = q[320 + rowA]; nvB = q[320 + rowB];
                    }
                    float saA = dot4(SA, a), saB = dot4(SBs, a);
                    saA = dpp_allsum16(saA); saB = dpp_allsum16(saB);
                    SA = SA * w + saA * bv + vA * kd; SBs = SBs * w + saB * bv + vB * kd;
                    pA[s] = dot4(SA, r); pB[s] = dot4(SBs, r);
                    w = nw; kd = nkd; bv = nbv; r = nr; a = na; vA = nvA; vB = nvB;
                }
                {
                    const float yA = rs16(pA, C.lane), yB = rs16(pB, C.lane);
                    const int sabs = SB * n + (C.lane & 15), t = d ? (T - 1 - sabs) : sabs;
                    yout[(size_t)t * 512 + rowA] = yA; yout[(size_t)t * 512 + rowB] = yB;
                }
            }
            __syncthreads();
        }
    }
}

__device__ __forceinline__ hf8 ld_h8(const hf* p) { return __builtin_bit_cast(hf8, *(const u32x4*)p); }
template <int NT, bool NA>
__device__ __forceinline__ void attn_item(const Params& P, int li, int idx, int lane, LAS unsigned char* vbuf) {
    unsigned char* ws = P.ws;
    const hf* QKV = (const hf*)(ws + Z_QKV);
    const int ql = lane & 15, g = lane >> 4;
    int b, head, tok_q, qoff, koff, voff;
    int ldil = 0, res = 0, nsub = 0, jq0 = 0, k0 = 0, grp = 0;
    int r = 0, cb = 0, r0 = 0, kc0 = 0, qc = 0, wc0 = 0;
    if (!NA) {
        const int qi = idx & 255; head = (idx >> 8) % 12; b = idx / (256 * 12);
        grp = head >> 2; ldil = 2 * grp; nsub = T >> ldil;
        const int per = nsub >> 4;
        res = qi / per; jq0 = (qi - res * per) * 16; k0 = jq0 - 64;
        tok_q = b * T + ((jq0 + ql) << ldil) + res;
        qoff = head * 64; koff = 768 + head * 64; voff = 1536 + head * 64;
    } else {
        cb = idx & 3; r = (idx >> 2) & 63; head = (idx >> 8) % 12; b = idx / (256 * 12);
        qc = 16 * cb + ql; tok_q = b * T + r * 64 + qc;
        r0 = min(max(r - 4, 0), 56); kc0 = min(max(16 * cb - 8, 0), 32); wc0 = min(max(qc - 8, 0), 48);
        qoff = 2304 + head * 64; koff = 3072 + head * 64; voff = 3840 + head * 64;
    }
    auto ktok = [&](int tl, int kin) -> int {
        if (!NA) { int jk = k0 + 16 * tl + kin; jk = min(max(jk, 0), nsub - 1); return b * T + (jk << ldil) + res; }
        else return b * T + (r0 + (tl >> 1)) * 64 + kc0 + 16 * (tl & 1) + kin;
    };
    const hf* qp = QKV + (size_t)tok_q * QKVW + qoff + 8 * g;
    const hf8 q0 = ld_h8(qp), q1 = ld_h8(qp + 32);
    f32x4 sc[NT];
    constexpr int KB = NT >= 16 ? 8 : NT;
#pragma unroll
    for (int t0 = 0; t0 < NT; t0 += KB) {
        hf8 kfa[KB], kfb[KB];
#pragma unroll
        for (int i = 0; i < KB; ++i) { const hf* kp = QKV + (size_t)ktok(t0 + i, ql) * QKVW + koff + 8 * g; kfa[i] = ld_h8(kp); kfb[i] = ld_h8(kp + 32); }
        asm volatile("" ::: "memory");
#pragma unroll
        for (int i = 0; i < KB; ++i) {
            f32x4 a = {0.f, 0.f, 0.f, 0.f};
            a = __builtin_amdgcn_mfma_f32_16x16x32_f16(kfa[i], q0, a, 0, 0, 0);
            a = __builtin_amdgcn_mfma_f32_16x16x32_f16(kfb[i], q1, a, 0, 0, 0);
            sc[t0 + i] = a;
        }
    }
    const float* bias = P.in[I_NA_BIAS] + ((size_t)li * 12 + head) * 15 * 31;
    float mx = -3.0e38f;
#pragma unroll
    for (int tl = 0; tl < NT; ++tl)
#pragma unroll
        for (int j = 0; j < 4; ++j) {
            float s = sc[tl][j]; bool ok;
            if (!NA) { const int jk = k0 + 16 * tl + 4 * g + j, dq = jk - (jq0 + ql); ok = (dq <= 64) && (dq >= -64) && (jk >= 0) && (jk < nsub); }
            else { const int kc = kc0 + 16 * (tl & 1) + 4 * g + j, dy = r0 + (tl >> 1) - r, dxi = min(max(kc - qc, -15), 15) + 15;
                   s = s * 0.125f + bias[(dy + 7) * 31 + dxi]; ok = (kc >= wc0) && (kc < wc0 + 16); }
            s = ok ? s : -1.0e30f; sc[tl][j] = s; mx = fmaxf(mx, s);
        }
    mx = fmaxf(mx, xor_shfl(mx, lane, 16)); mx = fmaxf(mx, xor_shfl(mx, lane, 32));
    float sum = 0.f;
#pragma unroll
    for (int tl = 0; tl < NT; ++tl)
#pragma unroll
        for (int j = 0; j < 4; ++j) { const float p = sc[tl][j] > -1.0e29f ? __expf(sc[tl][j] - mx) : 0.f; sc[tl][j] = p; sum += p; }
    sum += xor_shfl(sum, lane, 16); sum += xor_shfl(sum, lane, 32);
    const float inv = 1.0f / sum;
    f32x4 o[4];
#pragma unroll
    for (int et = 0; et < 4; ++et) o[et] = (f32x4){0.f, 0.f, 0.f, 0.f};
    constexpr int NP = NT / 2, VSTR = 136;
    const int vkey = lane >> 3, vch = lane & 7;
#pragma unroll
    for (int p0 = 0; p0 < NP; p0 += 4) {
        u32x4 vreg[4][4];
#pragma unroll
        for (int pp = 0; pp < 4; ++pp) if (p0 + pp < NP) {
#pragma unroll
            for (int i = 0; i < 4; ++i) { const int key = vkey + 8 * i; vreg[pp][i] = *(const u32x4*)(QKV + (size_t)ktok(2 * (p0 + pp) + (key >> 4), key & 15) * QKVW + voff + 8 * vch); }
        }
#pragma unroll
        for (int pp = 0; pp < 4; ++pp) if (p0 + pp < NP) {
            const int p = p0 + pp;
            hf8 pf;
#pragma unroll
            for (int j = 0; j < 4; ++j) { pf[j] = (hf)sc[2 * p][j]; pf[4 + j] = (hf)sc[2 * p + 1][j]; }
#pragma unroll
            for (int i = 0; i < 4; ++i) { LAS unsigned char* wp = vbuf + (vkey + 8 * i) * VSTR + 16 * vch;
                *(LAS u32x2*)wp = (u32x2){vreg[pp][i].x, vreg[pp][i].y}; *(LAS u32x2*)(wp + 8) = (u32x2){vreg[pp][i].z, vreg[pp][i].w}; }
            asm volatile("" ::: "memory");
#pragma unroll
            for (int et = 0; et < 4; ++et) {
                const LAS unsigned short* rp = (const LAS unsigned short*)(vbuf + (4 * g) * VSTR) + 16 * et + ql;
                u32x4 vv;
                vv.x = (unsigned)rp[0 * (VSTR / 2)] | ((unsigned)rp[1 * (VSTR / 2)] << 16); vv.y = (unsigned)rp[2 * (VSTR / 2)] | ((unsigned)rp[3 * (VSTR / 2)] << 16);
                vv.z = (unsigned)rp[16 * (VSTR / 2)] | ((unsigned)rp[17 * (VSTR / 2)] << 16); vv.w = (unsigned)rp[18 * (VSTR / 2)] | ((unsigned)rp[19 * (VSTR / 2)] << 16);
                o[et] = __builtin_amdgcn_mfma_f32_16x16x32_f16(__builtin_bit_cast(hf8, vv), pf, o[et], 0, 0, 0);
            }
            asm volatile("" ::: "memory");
        }
    }
    hf* op;
    if (!NA) op = (hf*)(ws + Z_DILO) + ((size_t)grp * M + tok_q) * 256 + (head & 3) * 64 + 4 * g;
    else op = (hf*)(ws + Z_YC) + (size_t)tok_q * 768 + head * 64 + 4 * g;
#pragma unroll
    for (int et = 0; et < 4; ++et) { const f32x4 v = o[et] * inv; u32x2 w; w.x = pkh(v.x, v.y); w.y = pkh(v.z, v.w); *(u32x2*)(op + 16 * et) = w; }
    if (!NA && g == 0) ((float*)(ws + Z_LSE))[((size_t)grp * M + tok_q) * 4 + (head & 3)] = mx + __logf(sum);
}
__device__ __forceinline__ void phase_attn(const Params& P, const Ctx& C, int li, int gw, int ngw) {
    constexpr int NITEM = 4 * 12 * 256;
    LAS unsigned char* vbuf = C.lds + C.wave * 16384;
    for (int it = gw; it < NITEM; it += ngw) attn_item<10, false>(P, li, it, C.lane, vbuf);
    for (int it = gw; it < NITEM; it += ngw) attn_item<16, true>(P, li, it, C.lane, vbuf);
}

__device__ __forceinline__ void phase_post(const Params& P, const Ctx& C, int li) {
    unsigned char* ws = P.ws;
    const float* YF = (const float*)(ws + Z_YF); const float* YBk = (const float*)(ws + Z_YBK);
    const hf* GRW = (const hf*)(ws + Z_GRW); const hf* BON = (const hf*)(ws + Z_BONUS); hf* YA = (hf*)(ws + Z_YA);
    const int c = C.tid;
    const float lg = P.in[I_RW_LNG][li * 512 + c], lb = P.in[I_RW_LNB][li * 512 + c];
    for (int m0 = C.bid * 8; m0 < M; m0 += C.G * 8) {
        float y[8], bo[8], gr[8];
#pragma unroll
        for (int u = 0; u < 8; ++u) { const size_t o = (size_t)(m0 + u) * 512 + c; y[u] = YF[o] + YBk[o]; bo[u] = (float)BON[o]; gr[u] = (float)GRW[o]; }
#pragma unroll
        for (int u = 0; u < 8; ++u) {
            const float mean = wave_sum(y[u], C.lane) * (1.0f / 64.0f), dl = y[u] - mean, var = wave_sum(dl * dl, C.lane) * (1.0f / 64.0f);
            const float yn = dl * rsqrtf(var + 64e-5f) * lg + lb;
            YA[(size_t)(m0 + u) * 512 + c] = (hf)((yn + bo[u]) * gr[u]);
        }
    }
    const hf* DO = (const hf*)(ws + Z_DILO); const float* LSE = (const float*)(ws + Z_LSE); hf* YB = (hf*)(ws + Z_YB);
    for (int i = C.bid * NTHR + C.tid; i < M * 64; i += C.G * NTHR) {
        const int m = i >> 6, c4 = i & 63, hq = c4 >> 4;
        const float l0 = LSE[((size_t)0 * M + m) * 4 + hq], l1 = LSE[((size_t)1 * M + m) * 4 + hq], l2 = LSE[((size_t)2 * M + m) * 4 + hq];
        const float mx = fmaxf(l0, fmaxf(l1, l2)); float w0 = __expf(l0 - mx), w1 = __expf(l1 - mx), w2 = __expf(l2 - mx); const float inv = 1.0f / (w0 + w1 + w2);
        w0 *= inv; w1 *= inv; w2 *= inv;
        const hf4 a = *(const hf4*)(DO + ((size_t)0 * M + m) * 256 + 4 * c4), bq = *(const hf4*)(DO + ((size_t)1 * M + m) * 256 + 4 * c4), cq = *(const hf4*)(DO + ((size_t)2 * M + m) * 256 + 4 * c4);
        u32x2 w; w.x = pkh(w0 * (float)a.x + w1 * (float)bq.x + w2 * (float)cq.x, w0 * (float)a.y + w1 * (float)bq.y + w2 * (float)cq.y);
        w.y = pkh(w0 * (float)a.z + w1 * (float)bq.z + w2 * (float)cq.z, w0 * (float)a.w + w1 * (float)bq.w + w2 * (float)cq.w);
        *(u32x2*)(YB + (size_t)m * 256 + 4 * c4) = w;
    }
}


#ifdef DBG
#ifndef DBG_LAST
#define DBG_LAST 6
#endif
constexpr size_t WS_DBG = WS_END;
__device__ __forceinline__ unsigned dbg_hash(unsigned x) { x ^= x >> 16; x *= 0x7feb352dU; x ^= x >> 15; x *= 0x846ca68bU; x ^= x >> 16; return x; }
__device__ __forceinline__ bool dbg_bad(float ref, float got) { return !(fabsf(ref - got) <= 0.03f * fabsf(ref) + 0.03f); }
__device__ __forceinline__ float dbg_cs(const float* RW, const float* mu, int m, int col) {
    const int t = m & (T - 1); const float x0 = RW[(size_t)m * RWP + col], xm = t > 0 ? RW[(size_t)(m - 1) * RWP + col] : 0.f, xp = t < T - 1 ? RW[(size_t)(m + 1) * RWP + col] : 0.f;
    return x0 + mu[col] * (0.5f * (xm + xp) - x0);
}
__device__ __forceinline__ float dbg_dot_hw(const hf* a, const float* w, int K, int ldw) { float acc = 0.f;
#pragma unroll 1
    for (int k = 0; k < K; ++k) acc += (float)a[k] * (float)(hf)w[(size_t)k * ldw]; return acc; }
__device__ __noinline__ void dbg_phase_checks(const Params& P, int ph, int tid, LAS float* st) {
    unsigned char* ws = P.ws; unsigned* dbg = (unsigned*)(ws + WS_DBG);
    const unsigned h1 = dbg_hash(tid * 4 + 1 + ph * 7919), h2 = dbg_hash(tid * 4 + 2 + ph * 7919), h3 = dbg_hash(tid * 4 + 3 + ph * 7919);
    const hf* H = (const hf*)(ws + WS_H); const hf* QKV = (const hf*)(ws + Z_QKV);
    if (ph == 3) {
        const float* RW = (const float*)(ws + Z_RWBUF); const float* mu = P.in[I_RW_MU];
        const int m = h1 % M, c = h2 % 512, hb = (c >> 6) << 6, b = m >> 12, t = m & (T - 1), h = c >> 6, e = c & 63;
        const float r = dbg_cs(RW, mu, m, c), k = dbg_cs(RW, mu, m, 512 + c), v = dbg_cs(RW, mu, m, 1024 + c);
        float ld[2], kdo[2] = {0.f, 0.f}, lro[2] = {0.f, 0.f}, bon = 0.f, gate = 0.f, nrm = 0.f;
#pragma unroll 1
        for (int l = 0; l < 96; ++l) gate += sigmoidf_(dbg_cs(RW, mu, m, 1664 + l)) * P.in[I_RW_G2][l * 512 + c];
#pragma unroll 1
        for (int n = 0; n < 64; ++n) { const float q = dbg_cs(RW, mu, m, 512 + hb + n) * P.in[I_RW_KK][hb + n]; nrm += q * q; }
        const float kk = k * P.in[I_RW_KK][c] / fmaxf(sqrtf(nrm), 1e-12f);
#pragma unroll 1
        for (int d = 0; d < 2; ++d) {
            float z = P.in[I_RW_W0][d * 512 + c];
#pragma unroll 1
            for (int l = 0; l < 32; ++l) z += tanhf(dbg_cs(RW, mu, m, 1536 + 32 * d + l)) * P.in[I_RW_W2][(d * 32 + l) * 512 + c];
            ld[d] = -0.60653066f * 1.44269504f * sigmoidf_(z);
            float dot = 0.f;
#pragma unroll 1
            for (int n = 0; n < 64; ++n) {
                float za = P.in[I_RW_A0][d * 512 + hb + n];
#pragma unroll 1
                for (int l = 0; l < 32; ++l) za += dbg_cs(RW, mu, m, 1600 + 32 * d + l) * P.in[I_RW_A2][(d * 32 + l) * 512 + hb + n];
                const float lr = sigmoidf_(za), kd = dbg_cs(RW, mu, m, 512 + hb + n) * (1.0f + (lr - 1.0f) * P.in[I_RW_KA][hb + n]);
                dot += dbg_cs(RW, mu, m, hb + n) * kd * P.in[I_RW_RK][hb + n];
                if (hb + n == c) { kdo[d] = kd; lro[d] = lr; }
            }
            bon += dot * v;
        }
        const hf* s1 = (const hf*)(ws + Z_S1) + ((size_t)(b * 8 + h) * T + t) * 192 + e;
        bool bad = dbg_bad(r, (float)s1[0]) || dbg_bad(-kk, (float)s1[64]) || dbg_bad(v, (float)s1[128]);
        for (int d = 0; d < 2; ++d) { const hf* s2 = (const hf*)(ws + Z_S2) + ((size_t)((d * 4 + b) * 8 + h) * T + t) * 192 + e;
            bad = bad || dbg_bad(ld[d], (float)s2[0]) || dbg_bad(kdo[d], (float)s2[64]) || dbg_bad(kk * lro[d], (float)s2[128]); }
        if (bad) atomicAdd(dbg + 0, 1u);
        if (dbg_bad(gate, (float)((const hf*)(ws + Z_GRW))[(size_t)m * 512 + c]) || dbg_bad(bon, (float)((const hf*)(ws + Z_BONUS))[(size_t)m * 512 + c])) atomicAdd(dbg + 1, 1u);
    } else if (ph == 4) {
        {
            const int chain = tid & 63, d = chain >> 5, b = (chain >> 3) & 3, h = chain & 7, i = h1 & 63;
            const hf* s1 = (const hf*)(ws + Z_S1) + (size_t)(b * 8 + h) * T * 192; const hf* s2 = (const hf*)(ws + Z_S2) + (size_t)((d * 4 + b) * 8 + h) * T * 192;
            const float* Y = (const float*)(ws + (d ? Z_YBK : Z_YF));
            for (int j = 0; j < 64; ++j) st[j * 512 + tid] = 0.f;
            bool bad = false;
#pragma unroll 1
            for (int s = 0; s < 256; ++s) {
                const int t = d ? T - 1 - s : s; const hf* p1 = s1 + (size_t)t * 192; const hf* p2 = s2 + (size_t)t * 192;
                float sa = 0.f;
#pragma unroll 1
                for (int j = 0; j < 64; ++j) sa += st[j * 512 + tid] * (float)p1[64 + j];
                const float v = (float)p1[128 + i]; float y = 0.f;
#pragma unroll 1
                for (int j = 0; j < 64; ++j) { const float nv = st[j * 512 + tid] * exp2f((float)p2[j]) + sa * (float)p2[128 + j] + v * (float)p2[64 + j]; st[j * 512 + tid] = nv; y += nv * (float)p1[j]; }
                if (!bad && dbg_bad(y, Y[((size_t)b * T + t) * 512 + h * 64 + i])) { bad = true; atomicMin(dbg + 12, (unsigned)s); }
            }
            if (bad) { atomicAdd(dbg + 2, 1u); atomicAdd(dbg + 10 + d, 1u); }
        }
        {
            const int tok = h1 % M, head = h2 % 12, e = h3 & 63, b = tok >> 12, t = tok & (T - 1), g = head >> 2, ldil = 2 * g, j = t >> ldil, res = t & ((1 << ldil) - 1), nsub = T >> ldil;
            const hf* q = QKV + (size_t)tok * QKVW + head * 64;
            float mx = -3e38f;
#pragma unroll 1
            for (int pass = 0; pass < 2; ++pass) {
                float sum = 0.f, acc = 0.f;
#pragma unroll 1
                for (int jk = max(0, j - 64); jk <= min(nsub - 1, j + 64); ++jk) {
                    const hf* kr = QKV + (size_t)(b * T + (jk << ldil) + res) * QKVW;
                    float sc = 0.f; for (int x = 0; x < 64; ++x) sc += (float)q[x] * (float)kr[768 + head * 64 + x];
                    if (pass == 0) mx = fmaxf(mx, sc); else { const float p = __expf(sc - mx); sum += p; acc += p * (float)kr[1536 + head * 64 + e]; }
                }
                if (pass == 1) {
                    const float o = acc / sum, lse = mx + __logf(sum);
                    if (dbg_bad(o, (float)((const hf*)(ws + Z_DILO))[((size_t)g * M + tok) * 256 + (head & 3) * 64 + e]) || dbg_bad(lse, ((const float*)(ws + Z_LSE))[((size_t)g * M + tok) * 4 + (head & 3)])) atomicAdd(dbg + 3, 1u);
                }
            }
        }
        {
            const int tok = h2 % M, head = h3 % 12, e = h1 & 63, b = tok >> 12, t = tok & (T - 1), r = t >> 6, qc = t & 63, r0 = min(max(r - 4, 0), 56), wc0 = min(max(qc - 8, 0), 48);
            const hf* q = QKV + (size_t)tok * QKVW + 2304 + head * 64; const float* bias = P.in[I_NA_BIAS] + (size_t)head * 15 * 31;
            float mx = -3e38f;
#pragma unroll 1
            for (int pass = 0; pass < 2; ++pass) {
                float sum = 0.f, acc = 0.f;
#pragma unroll 1
                for (int kidx = 0; kidx < 128; ++kidx) {
                    const int y = kidx >> 4, kc = wc0 + (kidx & 15);
                    const hf* kr = QKV + (size_t)(b * T + (r0 + y) * 64 + kc) * QKVW;
                    float sc = 0.f; for (int x = 0; x < 64; ++x) sc += (float)q[x] * (float)kr[3072 + head * 64 + x];
                    sc = sc * 0.125f + bias[(r0 + y - r + 7) * 31 + min(max(kc - qc, -15), 15) + 15];
                    if (pass == 0) mx = fmaxf(mx, sc); else { const float p = __expf(sc - mx); sum += p; acc += p * (float)kr[3840 + head * 64 + e]; }
                }
                if (pass == 1 && dbg_bad(acc / sum, (float)((const hf*)(ws + Z_YC))[(size_t)tok * 768 + head * 64 + e])) atomicAdd(dbg + 4, 1u);
            }
        }
    } else if (ph == 5) {
        {
            const int m = h1 % M, c = h2 % 512, hb = (c >> 6) << 6;
            const float* YF = (const float*)(ws + Z_YF); const float* YK = (const float*)(ws + Z_YBK);
            float mean = 0.f, var = 0.f;
            for (int n = 0; n < 64; ++n) mean += YF[(size_t)m * 512 + hb + n] + YK[(size_t)m * 512 + hb + n];
            mean *= (1.0f / 64.0f);
            for (int n = 0; n < 64; ++n) { const float dl = YF[(size_t)m * 512 + hb + n] + YK[(size_t)m * 512 + hb + n] - mean; var += dl * dl; }
            var *= (1.0f / 64.0f);
            const float yn = (YF[(size_t)m * 512 + c] + YK[(size_t)m * 512 + c] - mean) * rsqrtf(var + 64e-5f) * P.in[I_RW_LNG][c] + P.in[I_RW_LNB][c];
            const float ya = (yn + (float)((const hf*)(ws + Z_BONUS))[(size_t)m * 512 + c]) * (float)((const hf*)(ws + Z_GRW))[(size_t)m * 512 + c];
            const int c2 = h3 % 256, hq = c2 >> 6; const float* LSE = (const float*)(ws + Z_LSE); const hf* DO = (const hf*)(ws + Z_DILO);
            const float l0 = LSE[((size_t)0 * M + m) * 4 + hq], l1 = LSE[((size_t)1 * M + m) * 4 + hq], l2 = LSE[((size_t)2 * M + m) * 4 + hq], mx = fmaxf(l0, fmaxf(l1, l2));
            const float w0 = __expf(l0 - mx), w1 = __expf(l1 - mx), w2 = __expf(l2 - mx);
            const float yb = (w0 * (float)DO[((size_t)0 * M + m) * 256 + c2] + w1 * (float)DO[((size_t)1 * M + m) * 256 + c2] + w2 * (float)DO[((size_t)2 * M + m) * 256 + c2]) / (w0 + w1 + w2);
            if (dbg_bad(ya, (float)((const hf*)(ws + Z_YA))[(size_t)m * 512 + c]) || dbg_bad(yb, (float)((const hf*)(ws + Z_YB))[(size_t)m * 256 + c2])) atomicAdd(dbg + 5, 1u);
        }
        {
            const int row = h2 % M, col = h1 % NGATE;
            const float gt = sigmoidf_(dbg_dot_hw(H + (size_t)row * D, P.in[I_W_IN] + RW_COLS + QKVW + col, D, IN_COLS));
            if (dbg_bad(gt, (float)((const hf*)(ws + Z_GATES))[(size_t)row * NGATE + col])) atomicAdd(dbg + 6, 1u);
        }
    } else if (ph == 6) {
        const int row = h1 % M, col = h2 % D; const hf* GT = (const hf*)(ws + Z_GATES) + (size_t)row * NGATE;
        const float mg = (float)GT[col] * dbg_dot_hw((const hf*)(ws + Z_YA) + (size_t)row * 512, P.in[I_W_BRA] + col, 512, D)
                       + (float)GT[D + col] * dbg_dot_hw((const hf*)(ws + Z_YB) + (size_t)row * 256, P.in[I_W_BRB] + col, 256, D)
                       + (float)GT[2 * D + col] * dbg_dot_hw((const hf*)(ws + Z_YC) + (size_t)row * 768, P.in[I_W_BRC] + col, 768, D);
        if (dbg_bad(mg, (float)H[(size_t)row * D + col])) atomicAdd(dbg + 7, 1u);
    } else if (ph == 7) {
        const int row = h1 % M, col = h2 % D;
        const float o = P.in[I_X][(size_t)row * D + col] + dbg_dot_hw(H + (size_t)row * D, P.in[I_W_OUT] + col, D, D);
        if (dbg_bad(o, P.out[(size_t)row * D + col])) atomicAdd(dbg + 8, 1u);
    }
}
#endif
#ifndef ONLY
#define ONLY -1
#endif
#ifdef DBG
#define EN(n) ((n) <= DBG_LAST)
#else
#define EN(n) (ONLY < 0 || ONLY == (n))
#endif
constexpr int PH_PER_LAYER = 13, N_PHASES = 2 * PH_PER_LAYER + 1;
template <class Epi> __device__ __forceinline__ void run_gemm(const Ctx& C, const void* A, const void* Bt, int N, int K, const Epi& E, int Gs = -1, int cs = -1) {
    pg8::Gemm g{(const pg8::bf16_t*)A, (const pg8::bf16_t*)Bt, M, N, K}; pg8::StaticOrder S; S.init(M, N, Gs > 0 ? Gs : C.G, Gs > 0 ? cs : C.bid);
    pg8::gemm_phase<Epi, pg8::StaticOrder>(C.lds, g, S, E, C.tid);
}
#define XB_TMO      128
#define XB_XCNT(j)  (256  + 64 * (j))
#define XB_XSUB(j)  (1280 + 64 * (j))
#define XB_XGEN(j)  (2304 + 64 * (j))
#define XB_TOP      3328
#define XB_TOPGEN   3392
#define XCD_BAR_WORDS 3456
#define XB_SPIN_CAP (1u << 18)

__device__ __forceinline__ unsigned xb_ld(unsigned* p)              { return __hip_atomic_load(p, __ATOMIC_RELAXED, __HIP_MEMORY_SCOPE_AGENT); }
__device__ __forceinline__ unsigned xb_add(unsigned* p, unsigned v) { return __hip_atomic_fetch_add(p, v, __ATOMIC_RELAXED, __HIP_MEMORY_SCOPE_AGENT); }
__device__ __forceinline__ unsigned xb_xcc_id() { return (unsigned)__builtin_amdgcn_s_getreg((3 << 11) | 20) & 0xFu; }
#define XB_SPIN(cond, bar) do { unsigned _sp = 0; while (cond) { __builtin_amdgcn_s_sleep(1); \
    if ((++_sp & 255u) == 0u) { if (xb_ld(&(bar)[XB_TMO])) break; if (_sp > XB_SPIN_CAP) { atomicAdd(&(bar)[XB_TMO], 1u); break; } } } } while (0)

struct XcdBarrier {
    unsigned* bar; unsigned x;
    volatile LAS unsigned* st;
};

__device__ __forceinline__ XcdBarrier xcd_barrier_post(unsigned* bar, volatile LAS unsigned* st, bool leader) {
    XcdBarrier b; b.bar = bar; b.x = xb_xcc_id(); b.st = st;
    if (leader) (void)xb_add(&bar[XB_XCNT(b.x)], 1u);
    return b;
}
__device__ __forceinline__ void xcd_barrier_complete(unsigned* bar, unsigned x, unsigned& nloc, unsigned& nx) {
    const unsigned G = gridDim.x * gridDim.y * gridDim.z;
    unsigned sum, cnt, mine, sp = 0u;
    for (;;) {
        sum = 0u; cnt = 0u; mine = 0u;
#pragma unroll
        for (unsigned j = 0; j < 16; ++j) { const unsigned c = xb_ld(&bar[XB_XCNT(j)]); sum += c; cnt += (c > 0u) ? 1u : 0u; mine = (j == x) ? c : mine; }
        if (sum == G) break;
        __builtin_amdgcn_s_sleep(1);
        if ((++sp & 255u) == 0u) { if (xb_ld(&bar[XB_TMO])) break; if (sp > XB_SPIN_CAP) { atomicAdd(&bar[XB_TMO], 1u); break; } }
    }
    nloc = mine > 0u ? mine : 1u; nx = cnt > 0u ? cnt : 1u;
}

__device__ __forceinline__ void xcd_barrier(const XcdBarrier& b, bool leader) {
    asm volatile("s_waitcnt vmcnt(0)" ::: "memory");
    __syncthreads();
    if (leader) {
        unsigned* bar = b.bar;
        __builtin_amdgcn_s_waitcnt(0);
        unsigned nloc = b.st[0], nx = b.st[1];
        if (nloc == 0u) { xcd_barrier_complete(bar, b.x, nloc, nx); b.st[0] = nloc; b.st[1] = nx; }
        const unsigned old = xb_add(&bar[XB_XSUB(b.x)], 1u);
        const unsigned gen = old / nloc;
        if (old + 1u == (gen + 1u) * nloc) {
            __builtin_amdgcn_fence(__ATOMIC_RELEASE, "agent");
            asm volatile("s_waitcnt vmcnt(0)" ::: "memory");
            const unsigned og = xb_add(&bar[XB_TOP], 1u);
            const unsigned tg = og / nx;
            if (og + 1u == (tg + 1u) * nx) xb_add(&bar[XB_TOPGEN], 1u);
            else XB_SPIN(xb_ld(&bar[XB_TOPGEN]) == tg, bar);
            __builtin_amdgcn_fence(__ATOMIC_ACQUIRE, "agent");
            xb_add(&bar[XB_XGEN(b.x)], 1u);
            asm volatile("s_waitcnt vmcnt(0)" ::: "memory");
        } else {
            XB_SPIN(xb_ld(&bar[XB_XGEN(b.x)]) == gen, bar);
            __builtin_amdgcn_fence(__ATOMIC_ACQUIRE, "agent");
            asm volatile("s_waitcnt vmcnt(0)" ::: "memory");
        }
    }
    __syncthreads();
}


typedef __attribute__((address_space(4))) const Params* CPP;
__device__ __forceinline__ int lane_id() { int m1 = -1; asm volatile("" : "+s"(m1)); return __builtin_amdgcn_mbcnt_hi(m1, __builtin_amdgcn_mbcnt_lo(m1, 0)); }
constexpr size_t WS_BAR = WS_END + 1 * MiB;
constexpr size_t Z_B16 = WS_Z + 272 * MiB;
constexpr size_t Z_GA = WS_Z + 64 * MiB, WS_GA2 = WS_END + 2 * MiB, WS_NEED = WS_GA2 + 16 * MiB;
constexpr int LDS_BARST = 131072;
__device__ __forceinline__ void grid_seam(const XcdBarrier& xb, int wave_s) {
    const bool leader = wave_s == 0 && lane_id() == 0;
    xcd_barrier(xb, leader);
}
#define PHASE_BEGIN { CPP pp_ = (CPP)__builtin_amdgcn_kernarg_segment_ptr(); asm volatile("" : "+s"(pp_)); const Params& P = *(const Params*)pp_; \
    Ctx C; { int w_ = wave_s; asm volatile("" : "+s"(w_)); int t_ = w_ * 64 + lane_id(); asm volatile("" : "+v"(t_)); int b_ = blockIdx.x, g_ = gridDim.x; asm volatile("" : "+s"(b_), "+s"(g_)); \
      C.lds = (LAS unsigned char*)lds_raw; C.tid = t_; C.lane = t_ & 63; C.wave = __builtin_amdgcn_readfirstlane(t_ >> 6); C.bid = b_; C.G = g_; C.gw = b_ * NWAVES + C.wave; C.NGW = g_ * NWAVES; } \
    unsigned char* ws = P.ws; hf* H = (hf*)(ws + WS_H); (void)H;
#define PHASE_END }
#ifdef DBG
#define DBG_CHECK(ph) if (LI == 0 && (ph) >= 3 && (ph) <= DBG_LAST + 1) { PHASE_BEGIN \
        if (C.bid == 0) dbg_phase_checks(P, (ph), C.tid, (LAS float*)C.lds); \
        grid_seam(xb, wave_s); \
        if ((ph) == DBG_LAST + 1) { \
            const unsigned* dbg = (const unsigned*)(ws + WS_DBG); unsigned bits = 0; \
            for (int k2 = 0; k2 < 9; ++k2) bits |= (__hip_atomic_load(dbg + k2, __ATOMIC_RELAXED, __HIP_MEMORY_SCOPE_AGENT) > 0u ? 1u : 0u) << k2; \
            const int d1 = 1 + (bits & 7), d2 = (bits >> 3) & 7, d3 = (bits >> 6) & 7; \
            const float v0 = 1000.f * d1 + 100.f * d2, v1 = sqrtf(256.f * d3); \
            for (size_t i = (size_t)C.bid * NTHR + C.tid; i < (size_t)M * D; i += (size_t)C.G * NTHR) P.out[i] = i == 0 ? v0 : (i <= 65536 ? v1 : 0.f); \
            return true; } PHASE_END }
#else
#define DBG_CHECK(ph)
#endif
#define SEAM(ph) for (int rs_ = 0; rs_ < REP_SEAM; ++rs_) grid_seam(xb, wave_s); DBG_CHECK(ph)
#ifndef REP_GEMM
#define REP_GEMM 1
#endif
#ifndef REP_SCAN
#define REP_SCAN 1
#endif
#ifndef REP_ATTN
#define REP_ATTN 1
#endif
#ifndef REP_PRE
#define REP_PRE 1
#endif
#ifndef REP_SEAM
#define REP_SEAM 1
#endif
#ifndef REP_OTH
#define REP_OTH 1
#endif
#ifndef REP_MISC
#define REP_MISC 1
#endif
template <int LI> __device__ __forceinline__ bool run_layer(const XcdBarrier& xb, unsigned char* lds_raw, int wave_s) {
    constexpr int li = LI;
    PHASE_BEGIN
#ifdef DBG
        if (li == 0 && C.bid == 0 && C.tid < 16) ((unsigned*)(ws + WS_DBG))[C.tid] = C.tid == 12 ? 999u : 0u;
#endif
        for (int rep_ = 0; rep_ < REP_MISC; ++rep_) { phase_convert(P, C, li); __syncthreads(); phase_norm(li == 0 ? P.in[I_X] : P.out, P.in[I_NORM_MIX] + li * D, H, C); }
    PHASE_END SEAM(1)
    PHASE_BEGIN for (int rep_ = 0; rep_ < REP_GEMM; ++rep_) { { pg8::EpiIn1 E{(float*)(ws + Z_RWBUF), (hf*)(ws + Z_QKV)}; run_gemm(C, H, ws + WS_WIN, NIN1, D, E); } }
        {
            const int nfull = (64 * (NIN1 / 256)) % C.G;
            if (nfull > 0 && nfull < C.G) { if (C.bid >= nfull) phase_convert_part(P, C, li, 1, (C.bid - nfull) * NWAVES + C.wave, (C.G - nfull) * NWAVES); }
            else phase_convert_part(P, C, li, 1, C.gw, C.NGW);
        }
    PHASE_END SEAM(2)
    PHASE_BEGIN for (int rep_ = 0; rep_ < REP_PRE; ++rep_) { phase_rwkv_pre(P, C, li); } PHASE_END
    PHASE_BEGIN phase_rope(P, C); PHASE_END SEAM(3)
    PHASE_BEGIN {
        const int nscan = C.G >= 2 ? min(128, C.G / 2) : 1;
        if (C.G < 2) { phase_scan(P, C, 1); phase_attn(P, C, li, C.gw, C.NGW); phase_gate_lora(P, C, li, 0, 1); __syncthreads();
                       { pg8::EpiGates E{(hf*)(ws + Z_GA), D, GA_SPLIT, (hf*)(ws + WS_GA2), 1 << 30, nullptr, 0}; run_gemm(C, H, (hf*)(ws + WS_WIN) + (size_t)NIN1 * D, GA_EARLY, D, E); } }
        else if (C.bid < nscan) { for (int rep_ = 0; rep_ < REP_SCAN; ++rep_) { phase_scan(P, C, nscan); } }
        else { for (int rep_ = 0; rep_ < REP_ATTN; ++rep_) { phase_attn(P, C, li, (C.bid - nscan) * NWAVES + C.wave, (C.G - nscan) * NWAVES); }
               phase_gate_lora(P, C, li, C.bid - nscan, C.G - nscan);
               __syncthreads();
               { pg8::EpiGates E{(hf*)(ws + Z_GA), D, GA_SPLIT, (hf*)(ws + WS_GA2), 1 << 30, nullptr, 0}; run_gemm(C, H, (hf*)(ws + WS_WIN) + (size_t)NIN1 * D, GA_EARLY, D, E, C.G - nscan, C.bid - nscan); } }
    } PHASE_END SEAM(4)
    PHASE_BEGIN for (int rep_ = 0; rep_ < REP_MISC; ++rep_) { phase_post(P, C, li); } PHASE_END
    PHASE_BEGIN for (int rep_ = 0; rep_ < REP_GEMM; ++rep_) { { pg8::EpiGates E{(hf*)(ws + Z_GA) + GA_EARLY, D, GA_SPLIT, (hf*)(ws + WS_GA2) + GA_EARLY, D - GA_EARLY, (hf*)(ws + Z_GATES), 2 * D}; run_gemm(C, H, (hf*)(ws + WS_WIN) + (size_t)(NIN1 + GA_EARLY) * D, 3 * D - GA_EARLY, D, E); } } PHASE_END SEAM(5)
    PHASE_BEGIN for (int rep_ = 0; rep_ < REP_OTH; ++rep_) { pg8::EpiF16 Ea{(hf*)(ws + Z_MACC), D}; run_gemm(C, ws + Z_YA, ws + WS_WA, D, 512, Ea); } PHASE_END
    PHASE_BEGIN for (int rep_ = 0; rep_ < REP_OTH; ++rep_) { pg8::EpiF16 Eb{(hf*)(ws + Z_B16), D}; run_gemm(C, ws + Z_YB, ws + WS_WB, D, 256, Eb); } PHASE_END
    PHASE_BEGIN for (int rep_ = 0; rep_ < REP_OTH; ++rep_) { pg8::EpiMerge Ec{(const hf*)(ws + Z_GA), (const hf*)(ws + WS_GA2), (const hf*)(ws + Z_GATES), (const hf*)(ws + Z_MACC), (const hf*)(ws + Z_B16), H}; run_gemm(C, ws + Z_YC, ws + WS_WC, D, 768, Ec); } PHASE_END SEAM(6)
    PHASE_BEGIN for (int rep_ = 0; rep_ < REP_OTH; ++rep_) { pg8::EpiResid E{li == 0 ? P.in[I_X] : P.out, rep_ + 1 < REP_OTH ? (float*)(ws + Z_MACC) : P.out}; run_gemm(C, H, ws + WS_WO, D, D, E); } PHASE_END SEAM(7)
    PHASE_BEGIN for (int rep_ = 0; rep_ < REP_MISC; ++rep_) { phase_norm(P.out, P.in[I_NORM_FFN] + li * D, H, C); } PHASE_END SEAM(8)
    PHASE_BEGIN for (int rep_ = 0; rep_ < REP_GEMM; ++rep_) { { pg8::EpiF16 E{(hf*)(ws + Z_G), FF}; run_gemm(C, H, ws + WS_WG, FF, D, E); } }
        if (li == 0 && C.G == 256 && C.bid >= 128) phase_convert_part(P, C, 1, 0, (C.bid - 128) * NWAVES + C.wave, 128 * NWAVES);
        if (li == 1 && C.G == 256 && C.bid >= 128) { pg8::EpiF16 Ep{(hf*)(ws + Z_PP), D}; run_gemm(C, (hf*)(ws + WS_P16) + (size_t)li * M * PLE, ws + WS_WP, 1024, PLE, Ep, 128, C.bid - 128); }
    PHASE_END SEAM(9)
    PHASE_BEGIN for (int rep_ = 0; rep_ < REP_GEMM; ++rep_) { { pg8::EpiUp E{(const hf*)(ws + Z_G), P.in[I_CONV_W] + (size_t)li * 3 * FF, P.in[I_CONV_B] + (size_t)li * FF, (hf*)(ws + Z_ACT)}; run_gemm(C, H, ws + WS_WU, FF, D, E); } }
        if (li == 0 && C.G == 256 && C.bid >= 128) phase_convert_part(P, C, 1, 2, (C.bid - 128) * NWAVES + C.wave, 128 * NWAVES);
        if (li == 1 && C.G == 256 && C.bid >= 128) { pg8::EpiF16 Ep{(hf*)(ws + Z_PP) + 1024, D}; run_gemm(C, (hf*)(ws + WS_P16) + (size_t)li * M * PLE, (hf*)(ws + WS_WP) + (size_t)1024 * PLE, 1024, PLE, Ep, 128, C.bid - 128); }
    PHASE_END SEAM(10)
    PHASE_BEGIN for (int rep_ = 0; rep_ < REP_OTH; ++rep_) { pg8::EpiResid E{P.out, rep_ + 1 < REP_OTH ? (float*)(ws + Z_G) : P.out}; run_gemm(C, ws + Z_ACT, ws + WS_WD, D, FF, E); } PHASE_END SEAM(11)
    PHASE_BEGIN for (int rep_ = 0; rep_ < REP_MISC; ++rep_) { phase_norm(P.out, P.in[I_NORM_PLE] + li * D, H, C); } PHASE_END
    PHASE_BEGIN if (!(li == 1 && C.G == 256)) { for (int rep_ = 0; rep_ < REP_OTH; ++rep_) { pg8::EpiF16 E{(hf*)(ws + Z_PP), D}; run_gemm(C, (hf*)(ws + WS_P16) + (size_t)li * M * PLE, ws + WS_WP, D, PLE, E); } } PHASE_END SEAM(12)
    PHASE_BEGIN for (int rep_ = 0; rep_ < REP_OTH; ++rep_) { pg8::EpiPle E{(const hf*)(ws + Z_PP), P.out, rep_ + 1 < REP_OTH ? (float*)(ws + Z_G) : P.out}; run_gemm(C, H, ws + WS_WPG, D, D, E); } PHASE_END SEAM(13)
    return false;
}
__global__ void __launch_bounds__(NTHR, 2) mega_fwd(Params P_arg) {
    extern __shared__ __attribute__((aligned(16))) unsigned char lds_raw[];
    cg::grid_group grid = cg::this_grid();
    const int wave_s = __builtin_amdgcn_readfirstlane((int)threadIdx.x >> 6);
    if (threadIdx.x < 2) ((LAS unsigned*)((LAS unsigned char*)lds_raw + LDS_BARST))[threadIdx.x] = 0u;
    __syncthreads();
    XcdBarrier xb = xcd_barrier_post((unsigned*)(P_arg.ws + WS_BAR), (volatile LAS unsigned*)((LAS unsigned char*)lds_raw + LDS_BARST), threadIdx.x == 0);
    grid.sync();
    if (run_layer<0>(xb, lds_raw, wave_s)) return;
    if (run_layer<1>(xb, lds_raw, wave_s)) return;
    PHASE_BEGIN phase_final_norm(P.out, P.in[I_NORM_FINAL], C); PHASE_END
}

extern "C" void kernel_launch(void* const* d_in, const int* in_sizes, int n_in, void* d_out, int out_size, void* d_ws, size_t ws_size, hipStream_t stream) {
    static int grid = 0;
    if (grid == 0) {
        if (n_in != 30 || ws_size < WS_NEED) { fprintf(stderr, "kernel_launch: need 30 inputs and %zu bytes of workspace; got %d, %zu\n", (size_t)WS_END, n_in, ws_size); grid = -1; return; }
        int dev = 0, cus = 0, per_cu = 0;
        hipGetDevice(&dev); hipDeviceGetAttribute(&cus, hipDeviceAttributeMultiprocessorCount, dev);
        if (hipFuncSetAttribute((const void*)mega_fwd, hipFuncAttributeMaxDynamicSharedMemorySize, LDS_BYTES) != hipSuccess) fprintf(stderr, "kernel_launch: hipFuncSetAttribute failed\n");
        if (hipOccupancyMaxActiveBlocksPerMultiprocessor(&per_cu, (const void*)mega_fwd, NTHR, LDS_BYTES) != hipSuccess || per_cu < 1) { fprintf(stderr, "kernel_launch: occupancy query says %d\n", per_cu); per_cu = 1; }
        (void)hipGetLastError();
        grid = cus * 1;
        fprintf(stderr, "kernel_launch: grid %d (cus %d, per_cu %d), ws %zu\n", grid, cus, per_cu, ws_size);
    }
    if (grid < 0) return;
    if (hipMemsetAsync((char*)d_ws + WS_BAR, 0, 16384, stream) != hipSuccess) fprintf(stderr, "kernel_launch: memset of barrier words failed\n");
    Params p{};
    for (int i = 0; i < 30; ++i) p.in[i] = (const float*)d_in[i];
    p.out = (float*)d_out; p.ws = (unsigned char*)d_ws; p.ph_lo = 0; p.ph_hi = 0;
    void* args[] = {&p};
    hipError_t e = hipLaunchCooperativeKernel((const void*)mega_fwd, dim3(grid), dim3(NTHR), args, LDS_BYTES, stream);
    if (e != hipSuccess) fprintf(stderr, "kernel_launch: cooperative launch failed: %s\n", hipGetErrorString(e));
}
```
